# Optimizing an MI355X kernel written in HIP

```python
import math
import jax, jax.numpy as jnp
from jax import lax
import numpy as np

D_MODEL = 2048
BATCH = 4
SEQ = 4096
DEPTH = 2

N_EVEN = (DEPTH + 1) // 2
N_ODD = DEPTH // 2

CONV_CH = 1024
CONV_W = 31
DA_HEADS = 8
DA_HEAD_DIM = 64
DA_V_DIM = 2 * DA_HEAD_DIM
DA_QK = DA_HEADS * 2 * DA_HEAD_DIM
DA_WIDTH = DA_HEADS * DA_V_DIM
ROPE_THETA = 10000.0
Q_BLOCK = 128
SPLIT0 = [CONV_CH, CONV_CH, CONV_CH, DA_QK, DA_QK, DA_WIDTH, DA_WIDTH]
IN0 = sum(SPLIT0)
MIX0 = CONV_CH + DA_WIDTH
S5_WIDTH = D_MODEL
S5_GROUP = 16
S5_GROUPS = S5_WIDTH // S5_GROUP
S5_STATE = 64
S5_CHUNK = 128
EPS = 1e-6

kernel_name = "hybrid_conv_diffattn_s5_gated"


def rms_norm(x, g):
    xf = x.astype(jnp.float32)
    y = xf * lax.rsqrt(jnp.mean(xf * xf, axis=-1, keepdims=True) + EPS)
    return (y * g.astype(jnp.float32)).astype(x.dtype)


def layer_norm(x, g, b):
    xf = x.astype(jnp.float32)
    xc = xf - jnp.mean(xf, axis=-1, keepdims=True)
    var = jnp.mean(xc * xc, axis=-1, keepdims=True)
    return (xc * lax.rsqrt(var + EPS) * g.astype(jnp.float32) + b.astype(jnp.float32)).astype(x.dtype)


def rotary(x, pos):
    half = x.shape[-1] // 2
    freqs = ROPE_THETA ** (-jnp.arange(half, dtype=jnp.float32) / half)
    ang = pos.astype(jnp.float32)[:, None] * freqs[None, :]
    cos = jnp.cos(ang)[None, :, None, None, :]
    sin = jnp.sin(ang)[None, :, None, None, :]
    xf = x.astype(jnp.float32)
    x1, x2 = xf[..., :half], xf[..., half:]
    return jnp.concatenate([x1 * cos - x2 * sin, x2 * cos + x1 * sin], axis=-1)


def diff_attention(q, k, v, lam):
    b_, h_, _, s_, dh = q.shape
    nb = s_ // Q_BLOCK
    scale = dh ** -0.5
    qb = q.reshape(b_, h_, 2, nb, Q_BLOCK, dh).transpose(3, 0, 1, 2, 4, 5)
    k_pos = jnp.arange(s_)

    def block(args):
        qblk, i = args
        s = jnp.einsum('bhcqd,bhckd->bhcqk', qblk, k) * scale
        q_pos = i * Q_BLOCK + jnp.arange(Q_BLOCK)
        mask = k_pos[None, :] <= q_pos[:, None]
        s = jnp.where(mask, s, -jnp.inf)
        p = jax.nn.softmax(s, axis=-1)
        w = p[:, :, 0] - lam * p[:, :, 1]
        return jnp.einsum('bhqk,bhkd->bhqd', w, v)

    o = lax.map(block, (qb, jnp.arange(nb)))
    return o.transpose(1, 0, 3, 2, 4).reshape(b_, s_, h_, 2 * dh)


def even_layer(x, layer_idx, norm_g, w_in, conv_w, conv_b, cln_g, cln_b, qn_g, kn_g,
               lam_q1, lam_k1, lam_q2, lam_k2, subln_g, w_out):
    b_, s_, _ = x.shape
    pos = jnp.arange(s_)
    h = rms_norm(x, norm_g)
    proj = h @ w_in
    idx = [int(v) for v in np.cumsum(SPLIT0)[:-1]]
    a_val, a_glu, a_gate, q, k, v, b_gate = jnp.split(proj, idx, axis=-1)

    u = a_val * jax.nn.sigmoid(a_glu)
    kern = conv_w[:, None, :].astype(u.dtype)
    c = lax.conv_general_dilated(u, kern, window_strides=(1,), padding=[(CONV_W - 1, 0)],
                                 dimension_numbers=('NWC', 'WIO', 'NWC'),
                                 feature_group_count=CONV_CH) + conv_b
    c = jax.nn.silu(layer_norm(c, cln_g, cln_b))
    out_a = c * jax.nn.silu(a_gate)

    q = rotary(rms_norm(q.reshape(b_, s_, DA_HEADS, 2, DA_HEAD_DIM), qn_g), pos)
    k = rotary(rms_norm(k.reshape(b_, s_, DA_HEADS, 2, DA_HEAD_DIM), kn_g), pos)
    q = q.transpose(0, 2, 3, 1, 4)
    k = k.transpose(0, 2, 3, 1, 4)
    v = v.reshape(b_, s_, DA_HEADS, DA_V_DIM).astype(jnp.float32).transpose(0, 2, 1, 3)
    lam_init = 0.8 - 0.6 * math.exp(-0.3 * layer_idx)
    f32 = jnp.float32
    lam = (jnp.exp(jnp.sum(lam_q1.astype(f32) * lam_k1.astype(f32)))
           - jnp.exp(jnp.sum(lam_q2.astype(f32) * lam_k2.astype(f32))) + lam_init)
    o = diff_attention(q, k, v, lam)
    o = rms_norm(o, subln_g) * (1.0 - lam_init)
    out_b = o.reshape(b_, s_, DA_WIDTH).astype(x.dtype) * jax.nn.silu(b_gate)

    y = jnp.concatenate([out_a, out_b], axis=-1) @ w_out
    return x + y.astype(x.dtype)


def s5_scan(u, a_re, a_im, log_dt, b_re, b_im, c_re, c_im):
    f32 = jnp.float32
    a_re, a_im = a_re.astype(f32), a_im.astype(f32)
    b_re, b_im = b_re.astype(f32), b_im.astype(f32)
    c_re, c_im = c_re.astype(f32), c_im.astype(f32)
    b_, s_, g_, m_ = u.shape
    p_ = a_re.shape[-1]
    dt = jnp.exp(log_dt.astype(f32))[:, None]
    mag = jnp.exp(a_re * dt)
    lb_re, lb_im = mag * jnp.cos(a_im * dt), mag * jnp.sin(a_im * dt)
    den = a_re * a_re + a_im * a_im
    nr, ni = lb_re - 1.0, lb_im
    fr = (nr * a_re + ni * a_im) / den
    fi = (ni * a_re - nr * a_im) / den
    bb_re = fr[..., None] * b_re - fi[..., None] * b_im
    bb_im = fr[..., None] * b_im + fi[..., None] * b_re

    nc = s_ // S5_CHUNK
    uc = u.reshape(b_, nc, S5_CHUNK, g_, m_).transpose(1, 0, 2, 3, 4)
    ar = jnp.broadcast_to(lb_re[None, None], (1, S5_CHUNK, g_, p_))
    ai = jnp.broadcast_to(lb_im[None, None], (1, S5_CHUNK, g_, p_))

    def combine(e1, e2):
        ar1, ai1, br1, bi1 = e1
        ar2, ai2, br2, bi2 = e2
        return (ar2 * ar1 - ai2 * ai1, ar2 * ai1 + ai2 * ar1,
                ar2 * br1 - ai2 * bi1 + br2, ar2 * bi1 + ai2 * br1 + bi2)

    def step(carry, u_blk):
        h_re0, h_im0 = carry
        bu_re = jnp.einsum('blgm,gpm->blgp', u_blk, bb_re)
        bu_im = jnp.einsum('blgm,gpm->blgp', u_blk, bb_im)
        pr, pi, sr, si = lax.associative_scan(combine, (ar, ai, bu_re, bu_im), axis=1)
        h_re = sr + pr * h_re0[:, None] - pi * h_im0[:, None]
        h_im = si + pr * h_im0[:, None] + pi * h_re0[:, None]
        y = (jnp.einsum('blgp,gmp->blgm', h_re, c_re)
             - jnp.einsum('blgp,gmp->blgm', h_im, c_im))
        return (h_re[:, -1], h_im[:, -1]), y

    init = (jnp.zeros((b_, g_, p_), f32), jnp.zeros((b_, g_, p_), f32))
    _, ys = lax.scan(step, init, uc)
    return ys.transpose(1, 0, 2, 3, 4).reshape(b_, s_, g_, m_)


def odd_layer(x, norm_g, w_in, a_re, a_im, log_dt, b_re, b_im, c_re, c_im, d_skip,
              w_glu, b_glu, w_out):
    b_, s_, _ = x.shape
    h = rms_norm(x, norm_g)
    u, gate = jnp.split(h @ w_in, [S5_WIDTH], axis=-1)
    uf = u.astype(jnp.float32)
    y = s5_scan(uf.reshape(b_, s_, S5_GROUPS, S5_GROUP), a_re, a_im, log_dt,
                b_re, b_im, c_re, c_im).reshape(b_, s_, S5_WIDTH)
    y = y + d_skip.astype(jnp.float32) * uf
    z = jax.nn.gelu(y)
    z = z * jax.nn.sigmoid(z @ w_glu.astype(jnp.float32) + b_glu.astype(jnp.float32))
    out = z.astype(x.dtype) * jax.nn.silu(gate)
    return x + (out @ w_out).astype(x.dtype)


def setup_inputs(seed: int = 0) -> dict:
    key = jax.random.key(seed)
    ks = jax.random.split(key, 32)
    f32 = jnp.float32

    def nrm(k, shape, scale):
        return jax.random.normal(k, shape, f32) * scale

    ne, no = N_EVEN, N_ODD
    G, P, M, E = S5_GROUPS, S5_STATE, S5_GROUP, S5_WIDTH
    a_im_base = jnp.broadcast_to(math.pi * jnp.arange(P, dtype=f32), (no, G, P))
    return {
        "x": nrm(ks[0], (BATCH, SEQ, D_MODEL), 1.0),
        "e_norm_g": 1.0 + nrm(ks[1], (ne, D_MODEL), 0.02),
        "e_w_in": nrm(ks[2], (ne, D_MODEL, IN0), D_MODEL ** -0.5),
        "e_conv_w": nrm(ks[3], (ne, CONV_W, CONV_CH), CONV_W ** -0.5),
        "e_conv_b": nrm(ks[4], (ne, CONV_CH), 0.02),
        "e_cln_g": 1.0 + nrm(ks[5], (ne, CONV_CH), 0.02),
        "e_cln_b": nrm(ks[6], (ne, CONV_CH), 0.02),
        "e_qn_g": 1.0 + nrm(ks[7], (ne, DA_HEAD_DIM), 0.02),
        "e_kn_g": 1.0 + nrm(ks[8], (ne, DA_HEAD_DIM), 0.02),
        "e_lam_q1": nrm(ks[9], (ne, DA_HEAD_DIM), 0.1),
        "e_lam_k1": nrm(ks[10], (ne, DA_HEAD_DIM), 0.1),
        "e_lam_q2": nrm(ks[11], (ne, DA_HEAD_DIM), 0.1),
        "e_lam_k2": nrm(ks[12], (ne, DA_HEAD_DIM), 0.1),
        "e_subln_g": 1.0 + nrm(ks[13], (ne, DA_V_DIM), 0.02),
        "e_w_out": nrm(ks[14], (ne, MIX0, D_MODEL), MIX0 ** -0.5),
        "o_norm_g": 1.0 + nrm(ks[15], (no, D_MODEL), 0.02),
        "o_w_in": nrm(ks[16], (no, D_MODEL, 2 * E), D_MODEL ** -0.5),
        "o_A_re": -0.5 + nrm(ks[17], (no, G, P), 0.01),
        "o_A_im": a_im_base + nrm(ks[18], (no, G, P), 0.01),
        "o_log_dt": jax.random.uniform(ks[19], (no, G), f32, math.log(1e-3), math.log(1e-1)),
        "o_B_re": nrm(ks[20], (no, G, P, M), (2 * M) ** -0.5),
        "o_B_im": nrm(ks[21], (no, G, P, M), (2 * M) ** -0.5),
        "o_C_re": nrm(ks[22], (no, G, M, P), P ** -0.5),
        "o_C_im": nrm(ks[23], (no, G, M, P), P ** -0.5),
        "o_D": nrm(ks[24], (no, E), 1.0),
        "o_w_glu": nrm(ks[25], (no, E, E), E ** -0.5),
        "o_b_glu": nrm(ks[26], (no, E), 0.02),
        "o_w_out": nrm(ks[27], (no, E, D_MODEL), E ** -0.5),
    }


def reference(x, e_norm_g, e_w_in, e_conv_w, e_conv_b, e_cln_g, e_cln_b, e_qn_g, e_kn_g,
              e_lam_q1, e_lam_k1, e_lam_q2, e_lam_k2, e_subln_g, e_w_out,
              o_norm_g, o_w_in, o_A_re, o_A_im, o_log_dt, o_B_re, o_B_im, o_C_re, o_C_im,
              o_D, o_w_glu, o_b_glu, o_w_out):
    for layer in range(DEPTH):
        j = layer // 2
        if layer % 2 == 0:
            x = even_layer(x, layer, e_norm_g[j], e_w_in[j], e_conv_w[j], e_conv_b[j],
                           e_cln_g[j], e_cln_b[j], e_qn_g[j], e_kn_g[j],
                           e_lam_q1[j], e_lam_k1[j], e_lam_q2[j], e_lam_k2[j],
                           e_subln_g[j], e_w_out[j])
        else:
            x = odd_layer(x, o_norm_g[j], o_w_in[j], o_A_re[j], o_A_im[j], o_log_dt[j],
                          o_B_re[j], o_B_im[j], o_C_re[j], o_C_im[j], o_D[j],
                          o_w_glu[j], o_b_glu[j], o_w_out[j])
    return x
```

```cpp
#include <hip/hip_runtime.h>
#include <hip/hip_cooperative_groups.h>
#include <hip/hip_bf16.h>
#include <cstdio>
#include <cstdint>
#include <cmath>
namespace cg = cooperative_groups;
namespace pg8 {
#define PG8_LAS __attribute__((address_space(3)))
typedef unsigned short bf16_t;
typedef short bf16x8 __attribute__((ext_vector_type(8)));
typedef float f32x4 __attribute__((ext_vector_type(4)));
typedef unsigned u32x4 __attribute__((ext_vector_type(4)));
constexpr int BM = 256, BK = 64, HALF = 128, HTB = HALF * BK * 2  , STAGE_BYTES = 8 * HTB, NXCD = 8, WGM = 8;

__host__ __device__ __forceinline__ int lds_byte(int r, int c) { const int st = (r >> 4) * 2 + (c >> 5), rr = r & 15, cc = c & 31, ob = rr * 64 + cc * 2; return st * 1024 + (ob ^ (((ob >> 9) & 1) << 5)); }
__host__ __device__ __forceinline__ void stage_rc(int b, int& R, int& C) { const int st = b / 1024, sb = b % 1024, swz = sb ^ (((sb >> 9) & 1) << 5); R = (st >> 1) * 16 + swz / 64; C = (st & 1) * 32 + (swz % 64) / 2; }
__host__ __device__ __forceinline__ int perm32(int rho) { const int n = rho >> 4, i = rho & 15; return 8 * (i >> 2) + 4 * n + (i & 3); }

struct Unit { int pm, pn; };
struct Gemm { const bf16_t* A; const bf16_t* Bt; int M, N, K; };

struct StaticOrder {
    int nM, nN, nwg, G, c;
    __host__ __device__ void init(int M, int N, int G_, int c_) { nM = M / BM; nN = N / BM; nwg = nM * nN; G = G_; c = c_; }
    __host__ __device__ bool next(int i, Unit& u) const {
        const long L = (long)i * G + c; if (L >= nwg) return false;
        int wgid = (int)L; { const int q = nwg / NXCD, r = nwg % NXCD, xcd = wgid % NXCD, off = wgid / NXCD; wgid = (xcd < r ? xcd * (q + 1) : r * (q + 1) + (xcd - r) * q) + off; }
        const int nig = WGM * nN, gid = wgid / nig, fm = gid * WGM, gsz = (nM - fm) < WGM ? (nM - fm) : WGM;
        u.pm = fm + ((wgid % nig) % gsz); u.pn = (wgid % nig) / gsz; return true;
    }
    __device__ __forceinline__ void a_ready(const Unit&) const {}
    __device__ __forceinline__ void done(const Unit&) const {}
};

__device__ __forceinline__ unsigned cvt_pk_bf16(float lo, float hi) { unsigned r; asm volatile("v_cvt_pk_bf16_f32 %0, %1, %2" : "=v"(r) : "v"(lo), "v"(hi)); return r; }
typedef float f32x2 __attribute__((ext_vector_type(2)));
__device__ __forceinline__ f32x2 gelu_pk(f32x2 v) {
    const f32x2 av = __builtin_elementwise_abs(v), d = av * 0.2316418882f + 1.0f;
    f32x2 t; t.x = __builtin_amdgcn_rcpf(d.x); t.y = __builtin_amdgcn_rcpf(d.y);
    f32x2 q = t * 0.5307027145f + (-0.7265760135f); q = q * t + 0.7107068705f; q = q * t + (-0.142248368f); q = q * t + 0.127414796f; q = q * t;
    const f32x2 s = (v * v) * (-0.72134752044f);
    f32x2 e; e.x = __builtin_amdgcn_exp2f(s.x); e.y = __builtin_amdgcn_exp2f(s.y);
    const f32x2 m = v * (q * e), r = v - m;
    f32x2 o; o.x = v.x < 0.f ? m.x : r.x; o.y = v.y < 0.f ? m.y : r.y; return o;
}

template <int ACT  > struct EpiBf16 {
    static constexpr bool PERM = true, AFTER_DRAIN = false; static_assert(ACT == 0 || ACT == 1, "EpiBf16: ACT is 0 (none) or 1 (gelu_pk)");
    bf16_t* O; int ldc; const float* bias; int split_cols; size_t split_stride; float scale0;
    __device__ __forceinline__ void operator()(const f32x4 (&acc)[2][2][4][2], const Unit& u, int wr, int wc, int fr, int fq) const {
        const int row0 = u.pm * BM + wr * 64 + fr; int colt = u.pn * BM; bf16_t* base = O;
        float sc = 1.f; if (split_cols) { const int t = colt / split_cols; base += (size_t)t * split_stride; colt -= t * split_cols; if (t == 0) sc = scale0; }
        const int col0 = colt + wc * 32 + 8 * fq, bcol0 = u.pn * BM + wc * 32 + 8 * fq;
        f32x4 bv[2][2];
#pragma unroll
        for (int bj = 0; bj < 2; ++bj)
#pragma unroll
            for (int n = 0; n < 2; ++n) bv[bj][n] = bias ? *(const f32x4*)(bias + bcol0 + bj * HALF + 4 * n) : (f32x4){0.f, 0.f, 0.f, 0.f};
#pragma unroll
        for (int ai = 0; ai < 2; ++ai)
#pragma unroll
            for (int m = 0; m < 4; ++m) { bf16_t* rowp = base + (size_t)(row0 + ai * HALF + m * 16) * ldc + col0;
#pragma unroll
                for (int bj = 0; bj < 2; ++bj) { f32x4 v0 = acc[ai][bj][m][0] + bv[bj][0], v1 = acc[ai][bj][m][1] + bv[bj][1];
                    if (ACT == 1) { f32x2 a = gelu_pk((f32x2){v0[0], v0[1]}), b = gelu_pk((f32x2){v0[2], v0[3]}), c = gelu_pk((f32x2){v1[0], v1[1]}), d = gelu_pk((f32x2){v1[2], v1[3]});
                        v0 = (f32x4){a.x, a.y, b.x, b.y}; v1 = (f32x4){c.x, c.y, d.x, d.y}; }
                    v0 = v0 * sc; v1 = v1 * sc; u32x4 w; w.x = cvt_pk_bf16(v0[0], v0[1]); w.y = cvt_pk_bf16(v0[2], v0[3]); w.z = cvt_pk_bf16(v1[0], v1[1]); w.w = cvt_pk_bf16(v1[2], v1[3]);
                    *(u32x4*)(rowp + bj * HALF) = w; } }
    }
};
__device__ __forceinline__ float bflo(unsigned u) { return __uint_as_float(u << 16); }
__device__ __forceinline__ float bfhi(unsigned u) { return __uint_as_float(u & 0xffff0000u); }
__device__ __forceinline__ float sigm(float x) { return __builtin_amdgcn_rcpf(1.0f + __expf(-x)); }
struct EpiResF32 {
    static constexpr bool PERM = false, AFTER_DRAIN = false;
    const float* base; float* out; int ldc;
    __device__ __forceinline__ void operator()(const f32x4 (&acc)[2][2][4][2], const Unit& u, int wr, int wc, int fr, int fq) const {
        const int row0 = u.pm * BM + wr * 64 + fr, col0 = u.pn * BM + wc * 32 + 4 * fq;
#pragma unroll
        for (int ai = 0; ai < 2; ++ai)
#pragma unroll
            for (int m = 0; m < 4; ++m) { const size_t off = (size_t)(row0 + ai * HALF + m * 16) * ldc + col0;
#pragma unroll
                for (int bj = 0; bj < 2; ++bj)
#pragma unroll
                    for (int n = 0; n < 2; ++n) { const f32x4 b = *(const f32x4*)(base + off + bj * HALF + n * 16); *(f32x4*)(out + off + bj * HALF + n * 16) = b + acc[ai][bj][m][n]; } }
    }
};
struct EpiUG {
    static constexpr bool PERM = true, AFTER_DRAIN = false;
    bf16_t* Ugm; bf16_t* Gate; int mrows;
    __device__ __forceinline__ void operator()(const f32x4 (&acc)[2][2][4][2], const Unit& u, int wr, int wc, int fr, int fq) const {
        const int row0 = u.pm * BM + wr * 64 + fr, colb = u.pn * BM + wc * 32 + 8 * fq;
#pragma unroll
        for (int ai = 0; ai < 2; ++ai)
#pragma unroll
            for (int m = 0; m < 4; ++m) { const int row = row0 + ai * HALF + m * 16;
#pragma unroll
                for (int bj = 0; bj < 2; ++bj) { const int col = colb + bj * HALF; const f32x4 v0 = acc[ai][bj][m][0], v1 = acc[ai][bj][m][1];
                    u32x4 w; w.x = cvt_pk_bf16(v0[0], v0[1]); w.y = cvt_pk_bf16(v0[2], v0[3]); w.z = cvt_pk_bf16(v1[0], v1[1]); w.w = cvt_pk_bf16(v1[2], v1[3]);
                    if (col < 2048) *(u32x4*)(Ugm + ((size_t)(col >> 4) * mrows + row) * 16 + (col & 8)) = w;
                    else *(u32x4*)(Gate + (size_t)row * 2048 + (col - 2048)) = w; } }
    }
};
struct EpiGlu {
    static constexpr bool PERM = true, AFTER_DRAIN = false;
    const bf16_t* Z; const bf16_t* Gate; bf16_t* O; const float* bias;
    __device__ __forceinline__ void operator()(const f32x4 (&acc)[2][2][4][2], const Unit& u, int wr, int wc, int fr, int fq) const {
        const int row0 = u.pm * BM + wr * 64 + fr, colb = u.pn * BM + wc * 32 + 8 * fq;
        f32x4 bv[2][2];
#pragma unroll
        for (int bj = 0; bj < 2; ++bj)
#pragma unroll
            for (int n = 0; n < 2; ++n) bv[bj][n] = *(const f32x4*)(bias + colb + bj * HALF + 4 * n);
#pragma unroll
        for (int ai = 0; ai < 2; ++ai)
#pragma unroll
            for (int m = 0; m < 4; ++m) { const size_t roff = (size_t)(row0 + ai * HALF + m * 16) * 2048 + colb;
#pragma unroll
                for (int bj = 0; bj < 2; ++bj) { const f32x4 v0 = acc[ai][bj][m][0] + bv[bj][0], v1 = acc[ai][bj][m][1] + bv[bj][1];
                    const u32x4 zz = *(const u32x4*)(Z + roff + bj * HALF), gg = *(const u32x4*)(Gate + roff + bj * HALF);
                    float o[8]; const float a[8] = {v0[0], v0[1], v0[2], v0[3], v1[0], v1[1], v1[2], v1[3]};
#pragma unroll
                    for (int q = 0; q < 4; ++q) { const unsigned zw = zz[q], gw = gg[q]; const float z0 = bflo(zw), z1 = bfhi(zw), g0 = bflo(gw), g1 = bfhi(gw);
                        o[2 * q] = z0 * sigm(a[2 * q]) * (g0 * sigm(g0)); o[2 * q + 1] = z1 * sigm(a[2 * q + 1]) * (g1 * sigm(g1)); }
                    u32x4 w; w.x = cvt_pk_bf16(o[0], o[1]); w.y = cvt_pk_bf16(o[2], o[3]); w.z = cvt_pk_bf16(o[4], o[5]); w.w = cvt_pk_bf16(o[6], o[7]);
                    *(u32x4*)(O + roff + bj * HALF) = w; } }
    }
};

template <class Epi, class Sched, bool ALIGN_EPI = false, bool SP2 = false>
__device__ __forceinline__ void gemm_phase(PG8_LAS unsigned char* lds, const Gemm g, const Sched& S, const Epi& E) {
    const int tid = threadIdx.x, wid = __builtin_amdgcn_readfirstlane(tid >> 6), lane = tid & 63, wr = wid >> 2, wc = wid & 3, fr = lane & 15, fq = lane >> 4;
    const int K = g.K, nt = K / BK;
    unsigned voffA[2], voffB[2];
#pragma unroll
    for (int i = 0; i < 2; ++i) { int R, C; stage_rc(tid * 16 + i * 8192, R, C); const int Rb = Epi::PERM ? ((R & ~31) + perm32(R & 31)) : R;
        voffA[i] = (unsigned)(R * K + C) * 2u; voffB[i] = (unsigned)(Rb * K + C) * 2u; }
    const size_t kstep = (size_t)(BK * 2);
    const size_t hstep = (size_t)HALF * K * 2;
    const size_t tstep = 2 * hstep;
    const unsigned ldsw = (unsigned)wid * 1024u;
    const int aoff = lds_byte(wr * 64 + fr, fq * 8), boff = lds_byte(wc * 32 + fr, fq * 8);
#define PG8_SA(b, h) (((b) * 2 + (h)) * HTB)
#define PG8_SB(b, h) ((4 + (b) * 2 + (h)) * HTB)
#define PG8_STAGE(bufoff, gbase, voff) do { _Pragma("unroll") for (int _i = 0; _i < 2; ++_i) \
        __builtin_amdgcn_global_load_lds((const unsigned*)((const char*)(gbase) + (voff)[_i]), (PG8_LAS unsigned*)(lds + (bufoff) + ldsw + _i * 8192), 16, 0, 0); } while (0)
#define PG8_LDA(dst, b, h) do { _Pragma("unroll") for (int m = 0; m < 4; ++m) _Pragma("unroll") for (int k = 0; k < 2; ++k) dst[m][k] = *(const PG8_LAS bf16x8*)(lds + PG8_SA(b, h) + aoff + m * 2048 + k * 1024); } while (0)
#define PG8_LDB(dst, b, h) do { _Pragma("unroll") for (int n = 0; n < 2; ++n) _Pragma("unroll") for (int k = 0; k < 2; ++k) dst[n][k] = *(const PG8_LAS bf16x8*)(lds + PG8_SB(b, h) + boff + n * 2048 + k * 1024); } while (0)
#define PG8_MMA(ai, bj, At, Bt) do { __builtin_amdgcn_s_setprio(1); _Pragma("unroll") for (int m = 0; m < 4; ++m) _Pragma("unroll") for (int n = 0; n < 2; ++n) _Pragma("unroll") for (int k = 0; k < 2; ++k) \
        acc[ai][bj][m][n] = __builtin_amdgcn_mfma_f32_16x16x32_bf16(Bt[n][k], At[m][k], acc[ai][bj][m][n], 0, 0, 0); __builtin_amdgcn_s_setprio(0); } while (0)
#define PG8_WAIT_V(n) asm volatile("s_waitcnt vmcnt(" #n ")" ::: "memory")
#define PG8_WAIT_L(n) asm volatile("s_waitcnt lgkmcnt(" #n ")" ::: "memory")
#define PG8_BAR __builtin_amdgcn_s_barrier()
#define PG8_SCHED __builtin_amdgcn_sched_barrier(0)
    Unit cur, nxt; int ui = 0;
    if (!S.next(0, cur)) return;
    f32x4 acc[2][2][4][2];
#pragma unroll
    for (int a = 0; a < 2; ++a)
#pragma unroll
        for (int b = 0; b < 2; ++b)
#pragma unroll
            for (int m = 0; m < 4; ++m)
#pragma unroll
                for (int n = 0; n < 2; ++n) acc[a][b][m][n] = (f32x4){0.f, 0.f, 0.f, 0.f};
    bf16x8 At[4][2], B0[2][2], B1[2][2];
    const char* cA = (const char*)g.A + (size_t)cur.pm * tstep; const char* cB = (const char*)g.Bt + (size_t)cur.pn * tstep;
    S.a_ready(cur);
    if constexpr (SP2) {
        PG8_STAGE(PG8_SB(0, 0), cB, voffB); PG8_STAGE(PG8_SB(0, 1), cB + hstep, voffB); PG8_STAGE(PG8_SA(0, 0), cA, voffA); PG8_STAGE(PG8_SA(0, 1), cA + hstep, voffA);
        if (wr == 1) PG8_BAR;
        PG8_WAIT_V(2); PG8_BAR;
        PG8_STAGE(PG8_SB(1, 0), cB + kstep, voffB); PG8_STAGE(PG8_SA(1, 0), cA + kstep, voffA); PG8_STAGE(PG8_SB(1, 1), cB + hstep + kstep, voffB);
        PG8_WAIT_V(6); PG8_BAR;
    } else {
        PG8_STAGE(PG8_SB(0, 0), cB, voffB); PG8_STAGE(PG8_SA(0, 0), cA, voffA); PG8_STAGE(PG8_SB(0, 1), cB + hstep, voffB); PG8_STAGE(PG8_SA(0, 1), cA + hstep, voffA);
        if (wr == 1) PG8_BAR;
        PG8_WAIT_V(4); PG8_BAR;
        PG8_STAGE(PG8_SB(1, 0), cB + kstep, voffB); PG8_STAGE(PG8_SA(1, 0), cA + kstep, voffA); PG8_STAGE(PG8_SB(1, 1), cB + hstep + kstep, voffB);
        PG8_WAIT_V(6); PG8_BAR;
    }
    for (;;) {
        const bool has_next = S.next(ui + 1, nxt);
        const char* nA = has_next ? (const char*)g.A + (size_t)nxt.pm * tstep : cA; const char* nB = has_next ? (const char*)g.Bt + (size_t)nxt.pn * tstep : cB;
        for (int t = 0; t < nt; t += 2) {
            const bool last = (t == nt - 2);
            const char* a1 = cA + (size_t)(t + 1) * kstep;
            const char* a2 = last ? nA : cA + (size_t)(t + 2) * kstep; const char* b2 = last ? nB : cB + (size_t)(t + 2) * kstep;
            const char* a3 = a2 + kstep; const char* b3 = b2 + kstep;
            if (last && has_next) S.a_ready(nxt);
            if constexpr (SP2) {
            PG8_LDB(B0, 0, 0); PG8_LDB(B1, 0, 1); PG8_SCHED; PG8_LDA(At, 0, 0); PG8_STAGE(PG8_SA(1, 1), a1 + hstep, voffA);
            PG8_WAIT_V(8); PG8_WAIT_L(0); PG8_BAR; PG8_MMA(0, 0, At, B0); PG8_MMA(0, 1, At, B1); PG8_BAR; PG8_SCHED;
            PG8_LDA(At, 0, 1); PG8_STAGE(PG8_SB(0, 0), b2, voffB); PG8_STAGE(PG8_SB(0, 1), b2 + hstep, voffB); PG8_STAGE(PG8_SA(0, 0), a2, voffA);
            PG8_WAIT_V(8); PG8_WAIT_L(0); PG8_BAR; PG8_MMA(1, 0, At, B0); PG8_MMA(1, 1, At, B1); PG8_BAR; PG8_SCHED;
            PG8_LDB(B0, 1, 0); PG8_LDB(B1, 1, 1); PG8_SCHED; PG8_LDA(At, 1, 0); PG8_STAGE(PG8_SA(0, 1), a2 + hstep, voffA);
            PG8_WAIT_V(8); PG8_WAIT_L(0); PG8_BAR; PG8_MMA(0, 0, At, B0); PG8_MMA(0, 1, At, B1); PG8_BAR; PG8_SCHED;
            PG8_LDA(At, 1, 1); PG8_STAGE(PG8_SB(1, 0), b3, voffB); PG8_STAGE(PG8_SB(1, 1), b3 + hstep, voffB); PG8_STAGE(PG8_SA(1, 0), a3, voffA);
            PG8_WAIT_V(8); PG8_WAIT_L(0); PG8_BAR; PG8_MMA(1, 0, At, B0); PG8_MMA(1, 1, At, B1); PG8_BAR; PG8_SCHED;
            } else {
            PG8_LDB(B0, 0, 0); PG8_SCHED; PG8_LDA(At, 0, 0); PG8_STAGE(PG8_SA(1, 1), a1 + hstep, voffA);
            PG8_WAIT_L(8); PG8_BAR; PG8_WAIT_L(0); PG8_MMA(0, 0, At, B0); PG8_BAR; PG8_SCHED;
            PG8_LDB(B1, 0, 1); PG8_STAGE(PG8_SB(0, 0), b2, voffB);
            PG8_BAR; PG8_WAIT_L(0); PG8_MMA(0, 1, At, B1); PG8_BAR;
            PG8_LDA(At, 0, 1); PG8_STAGE(PG8_SA(0, 0), a2, voffA);
            PG8_BAR; PG8_WAIT_L(0); PG8_MMA(1, 0, At, B0); PG8_BAR; PG8_SCHED;
            PG8_STAGE(PG8_SB(0, 1), b2 + hstep, voffB);
            PG8_WAIT_V(6); PG8_BAR; PG8_MMA(1, 1, At, B1); PG8_BAR;
            PG8_LDB(B0, 1, 0); PG8_SCHED; PG8_LDA(At, 1, 0); PG8_STAGE(PG8_SA(0, 1), a2 + hstep, voffA);
            PG8_WAIT_L(8); PG8_BAR; PG8_WAIT_L(0); PG8_MMA(0, 0, At, B0); PG8_BAR; PG8_SCHED;
            PG8_LDB(B1, 1, 1); PG8_STAGE(PG8_SB(1, 0), b3, voffB);
            PG8_BAR; PG8_WAIT_L(0); PG8_MMA(0, 1, At, B1); PG8_BAR;
            PG8_LDA(At, 1, 1); PG8_STAGE(PG8_SA(1, 0), a3, voffA);
            PG8_BAR; PG8_WAIT_L(0); PG8_MMA(1, 0, At, B0); PG8_BAR; PG8_SCHED;
            PG8_STAGE(PG8_SB(1, 1), b3 + hstep, voffB);
            PG8_WAIT_V(6); PG8_BAR; PG8_MMA(1, 1, At, B1); PG8_BAR;
            }
        }
        if constexpr (ALIGN_EPI) { if (wr == 0) PG8_BAR; }
        if constexpr (!Epi::AFTER_DRAIN) { E(acc, cur, wr, wc, fr, fq); S.done(cur); }
        if (!has_next) break;
#pragma unroll
        for (int a = 0; a < 2; ++a)
#pragma unroll
            for (int b = 0; b < 2; ++b)
#pragma unroll
                for (int m = 0; m < 4; ++m)
#pragma unroll
                    for (int n = 0; n < 2; ++n) acc[a][b][m][n] = (f32x4){0.f, 0.f, 0.f, 0.f};
        cur = nxt; cA = nA; cB = nB; ++ui;
        if constexpr (ALIGN_EPI) { if (wr == 1) PG8_BAR; }
    }
    PG8_WAIT_V(0);
    if constexpr (!ALIGN_EPI) { if (wr == 0) PG8_BAR; }
    PG8_BAR;
    if constexpr (Epi::AFTER_DRAIN) { E.fused(acc, cur, wr, wc, fr, fq, lds, wid, lane); S.done(cur); }
#undef PG8_SA
#undef PG8_SB
#undef PG8_STAGE
#undef PG8_LDA
#undef PG8_LDB
#undef PG8_MMA
#undef PG8_WAIT_V
#undef PG8_WAIT_L
#undef PG8_BAR
#undef PG8_SCHED
}
}

#ifndef PG8_SP2
#define PG8_SP2 true
#endif
#ifndef PG8_ALIGN
#define PG8_ALIGN true
#endif
namespace attn_body {
using bf16=__hip_bfloat16;
using bf16x8=__attribute__((ext_vector_type(8)))short;
using s16x4=__attribute__((ext_vector_type(4)))short;
using f32x16=__attribute__((ext_vector_type(16)))float;
using u32x4=__attribute__((ext_vector_type(4)))unsigned;
constexpr int SEQ=4096,D=64,DM=7168,OPITCH=2048;
constexpr int NW=8,QBLK=32,QB=QBLK*NW,KVBLK=64,NQB=SEQ/QB;
constexpr int ATTN_PITCH=DM, ATTN_UNIT_ROWS=QB;
__device__ __forceinline__ int crow(int r,int hi){return (r&3)+8*(r>>2)+4*hi;}
#define SBAR() __builtin_amdgcn_sched_barrier(0)
__device__ __forceinline__ void cmask(f32x16&p0,f32x16&p1,int jb,int qrel,int hi){
  const float NEG=-INFINITY; int kb=64*jb+4*hi;
  #pragma unroll
  for(int r=0;r<16;++r){int kv=kb+(r&3)+8*(r>>2); if(kv>qrel)p0[r]=NEG; if(kv+32>qrel)p1[r]=NEG;}
}

constexpr int NSLOT=3, SLOTB=8192;
constexpr int LDS_K=0, LDS_V=NSLOT*SLOTB, LDS_WS=2*NSLOT*SLOTB, LDS_OST=LDS_WS+NW*64*4, LDS_BYTES=LDS_OST+NW*4096;
constexpr float C2=0.125f*1.4426950408889634f;
__device__ __forceinline__ void glds16(const void*gsrc,unsigned lds_dst){unsigned keep;
  asm volatile("s_mov_b32 %0, m0\n\ts_mov_b32 m0, %2\n\ts_nop 0\n\tglobal_load_lds_dwordx4 %1, off\n\ts_mov_b32 m0, %0":"=&s"(keep):"v"(gsrc),"s"(lds_dst):"memory");}
__device__ __forceinline__ float max3f(float a,float b,float c){float r;asm("v_max3_f32 %0, %1, %2, %3":"=v"(r):"v"(a),"v"(b),"v"(c));return r;}
__device__ __forceinline__ float max2f(float a,float b){float r;asm("v_max_f32_e32 %0, %1, %2":"=v"(r):"v"(a),"v"(b));return r;}
__device__ __forceinline__ float fadd_s(float a,float b){float r;asm("v_add_f32_e32 %0, %1, %2":"=v"(r):"v"(a),"v"(b));return r;}
__device__ __forceinline__ float fsub_s(float a,float b){float r;asm("v_sub_f32_e32 %0, %1, %2":"=v"(r):"v"(a),"v"(b));return r;}
typedef float f32x2_t __attribute__((ext_vector_type(2))); typedef __bf16 bf16x2_t __attribute__((ext_vector_type(2)));
__device__ __forceinline__ unsigned cvtpk_s(float lo,float hi){f32x2_t v={lo,hi};bf16x2_t b=__builtin_convertvector(v,bf16x2_t);return __builtin_bit_cast(unsigned,b);}
#define WAIT_BAR(N) asm volatile("s_waitcnt vmcnt(" #N ") lgkmcnt(0)\n\ts_barrier":::"memory")

__device__ __forceinline__ void qkt(f32x16&p0,f32x16&p1,const char*Kslot,const bf16x8*qr,const f32x16&negm,int r32,int hi){
  const char*kb=Kslot+hi*1024+r32*16;
  #pragma unroll
  for(int d0=0;d0<4;++d0){
    const bf16x8 b0=*reinterpret_cast<const bf16x8*>(kb+d0*2048);
    const bf16x8 b1=*reinterpret_cast<const bf16x8*>(kb+d0*2048+512);
    if(d0==0){p0=__builtin_amdgcn_mfma_f32_32x32x16_bf16(b0,qr[0],negm,0,0,0);p1=__builtin_amdgcn_mfma_f32_32x32x16_bf16(b1,qr[0],negm,0,0,0);}
    else{p0=__builtin_amdgcn_mfma_f32_32x32x16_bf16(b0,qr[d0],p0,0,0,0);p1=__builtin_amdgcn_mfma_f32_32x32x16_bf16(b1,qr[d0],p1,0,0,0);}}
}
typedef __attribute__((address_space(3))) const char* lds_cptr;
typedef short v4i16_t __attribute__((ext_vector_type(4)));
__device__ __forceinline__ void kload8(bf16x8*kf,lds_cptr kp){
  kf[0]=*(const __attribute__((address_space(3))) bf16x8*)(kp);      kf[1]=*(const __attribute__((address_space(3))) bf16x8*)(kp+512);
  kf[2]=*(const __attribute__((address_space(3))) bf16x8*)(kp+2048); kf[3]=*(const __attribute__((address_space(3))) bf16x8*)(kp+2560);
  kf[4]=*(const __attribute__((address_space(3))) bf16x8*)(kp+4096); kf[5]=*(const __attribute__((address_space(3))) bf16x8*)(kp+4608);
  kf[6]=*(const __attribute__((address_space(3))) bf16x8*)(kp+6144); kf[7]=*(const __attribute__((address_space(3))) bf16x8*)(kp+6656);
}
__device__ __forceinline__ void kload2(bf16x8*kf,lds_cptr kp,int j){ kf[2*j]=*(const __attribute__((address_space(3))) bf16x8*)(kp+j*2048); kf[2*j+1]=*(const __attribute__((address_space(3))) bf16x8*)(kp+j*2048+512); }
__device__ __forceinline__ s16x4 vtr(lds_cptr p){ return __builtin_bit_cast(s16x4,__builtin_amdgcn_ds_read_tr16_b64_v4i16((__attribute__((address_space(3))) v4i16_t*)p)); }
__device__ __forceinline__ float rowmax(const f32x16&p0,const f32x16&p1){
  float a=max3f(p0[0],p0[1],p1[0]),b=max3f(p0[2],p0[3],p1[1]);a=max3f(a,p1[2],p1[3]);
  #pragma unroll
  for(int r=4;r<16;r+=4){a=max3f(a,p0[r],p0[r+1]);b=max3f(b,p0[r+2],p0[r+3]);a=max3f(a,p1[r],p1[r+1]);b=max3f(b,p1[r+2],p1[r+3]);}
  const float m=max2f(a,b);
  auto rr=__builtin_amdgcn_permlane32_swap(__float_as_uint(m),__float_as_uint(m),false,false);
  return max2f(__uint_as_float(rr[0]),__uint_as_float(rr[1]));
}
__device__ __forceinline__ void pv(f32x16*o,int vb,bf16x8 pa0,bf16x8 pa1,bf16x8 pa2,bf16x8 pa3){
  #pragma unroll
  for(int d0=0;d0<2;++d0){s16x4 lo[4],hi[4];
    #pragma unroll
    for(int ks=0;ks<4;++ks){
      asm volatile("ds_read_b64_tr_b16 %0,%1 offset:%c2":"=&v"(lo[ks]):"v"(vb),"i"(d0*4096+ks*1024):"memory");
      asm volatile("ds_read_b64_tr_b16 %0,%1 offset:%c2":"=&v"(hi[ks]):"v"(vb),"i"(d0*4096+ks*1024+512):"memory");}
    asm volatile("s_waitcnt lgkmcnt(0)":::"memory");SBAR();
    #define PK(k) (bf16x8){lo[k][0],lo[k][1],lo[k][2],lo[k][3],hi[k][0],hi[k][1],hi[k][2],hi[k][3]}
    o[d0]=__builtin_amdgcn_mfma_f32_32x32x16_bf16(pa0,PK(0),o[d0],0,0,0);
    o[d0]=__builtin_amdgcn_mfma_f32_32x32x16_bf16(pa1,PK(1),o[d0],0,0,0);
    o[d0]=__builtin_amdgcn_mfma_f32_32x32x16_bf16(pa2,PK(2),o[d0],0,0,0);
    o[d0]=__builtin_amdgcn_mfma_f32_32x32x16_bf16(pa3,PK(3),o[d0],0,0,0);
    #undef PK
  }
}

#ifndef ATTN_STORE16
#define ATTN_STORE16(p,v) (*(u32x4*)(p)=(v))
#endif
template<int THRL> __device__ __forceinline__ void attn_unit(int b,int qb,const bf16*Q,const bf16*K,const bf16*V,bf16*O,char*shm){
  const int tid=threadIdx.x,lane=tid&63,r32=lane&31,hi=lane>>5; const int wid=__builtin_amdgcn_readfirstlane(tid>>6);
  const long rowbase=(long)b*SEQ; const int q0=qb*QB;
  const bf16*Qw=Q+(rowbase+q0+wid*QBLK)*DM;
  const bf16*Kh=K+rowbase*DM,*Vh=V+rowbase*DM;
  const unsigned lds0=(unsigned)(uintptr_t)shm;
  float*wsf=(float*)(shm+LDS_WS)+wid*64;
  const bf16*ksrc=Kh+(long)lane*DM+wid*8;
  const bf16*vsrc=Vh+(long)(16*(wid&3)+(lane>>2))*DM+(wid>>2)*32+(lane&3)*8;
  const unsigned kdst=lds0+LDS_K+wid*1024, vdst=lds0+LDS_V+wid*1024;
  #define DMA_K(t,slot) glds16(ksrc+(long)(t)*KVBLK*DM,(unsigned)__builtin_amdgcn_readfirstlane(kdst+(slot)))
  #define DMA_V(t,slot) glds16(vsrc+(long)(t)*KVBLK*DM,(unsigned)__builtin_amdgcn_readfirstlane(vdst+(slot)))
  const int vb0=(int)(lds0+LDS_V)+((lane>>4)&1)*32+(lane&3)*8+(4*hi+((lane&15)>>2))*64;
  const char*Kbase=shm+LDS_K; bf16x8 kf[8];
  const lds_cptr shm3=(lds_cptr)shm; const lds_cptr kp0=shm3+LDS_K+hi*1024+r32*16; const lds_cptr vp0=shm3+LDS_V+((lane>>4)&1)*32+(lane&3)*8+(4*hi+((lane&15)>>2))*64;
  const int NT=(q0+QB)/KVBLK;
  DMA_K(0,0);DMA_V(0,0);DMA_K(1,SLOTB);
  bf16x8 qr[4];
  #pragma unroll
  for(int d0=0;d0<4;++d0)qr[d0]=*reinterpret_cast<const bf16x8*>(&Qw[(long)r32*DM+d0*16+hi*8]);
  float mhat=0.f,l_reg=0.f;f32x16 o[2];o[0]=f32x16{};o[1]=f32x16{};f32x16 negm=f32x16{};asm volatile("":"+v"(negm));
  const int qrel=wid*QBLK+r32;
  #define CMASK(P0,P1,t) do{int jb_=(t)-(NT-4); if(jb_>=0)cmask(P0,P1,jb_,qrel,hi);}while(0)
  bool resc=false;
  #define START(P0,P1) do{ const float rm=rowmax(P0,P1); resc=false; \
    { const float dl=rm; mhat=fadd_s(mhat,dl); \
      _Pragma("unroll") for(int r=0;r<16;++r){P0[r]=fsub_s(P0[r],dl);P1[r]=fsub_s(P1[r],dl);} \
      _Pragma("unroll") for(int r=0;r<16;++r)negm[r]=-mhat; asm volatile("":"+v"(negm)); } \
    _Pragma("unroll") for(int r=0;r<16;++r)P0[r]=__builtin_amdgcn_exp2f(P0[r]); }while(0)
  #define RESC() do{ if(resc){ asm volatile("s_waitcnt lgkmcnt(0)":::"memory"); \
      _Pragma("unroll") for(int d_=0;d_<2;++d_) _Pragma("unroll") for(int r=0;r<16;++r)o[d_][r]*=wsf[crow(r,hi)]; } }while(0)
  f32x16 pA0,pA1,pB0,pB1;
  int sl_prev=0,sl_cur=0,sl_next=SLOTB;
  #define ROT() do{sl_prev=sl_cur;sl_cur=sl_next;sl_next=(sl_next==(NSLOT-1)*SLOTB)?0:sl_next+SLOTB;}while(0)
  DMA_K(2,2*SLOTB);
  WAIT_BAR(3);
  qkt(pA0,pA1,Kbase,qr,negm,r32,hi);asm volatile("s_nop 15\n\ts_nop 7":"+v"(pA0),"+v"(pA1));CMASK(pA0,pA1,0);
  START(pA0,pA1);
  _Pragma("unroll") for(int r=0;r<16;++r)pA1[r]=__builtin_amdgcn_exp2f(pA1[r]);
  WAIT_BAR(0);
  DMA_K(3,0);DMA_V(1,SLOTB);
  ROT();
  kload8(kf,kp0+sl_cur);
  WAIT_BAR(2);
  s16x4 vlo[8],vhi[8]; u32x4 pw0,pw1,pw2,pw3;
  #define PKW(P,B) cvtpk_s(P[B],P[B+1])
  #define PAF(k) __builtin_bit_cast(bf16x8,pw##k)
  #define VFR(i) (bf16x8){vlo[i][0],vlo[i][1],vlo[i][2],vlo[i][3],vhi[i][0],vhi[i][1],vhi[i][2],vhi[i][3]}
  #define PIN(x) asm volatile("":"+v"(x))
  #define MX3(a,b,c) __builtin_fmaxf(__builtin_fmaxf((a),(b)),(c))
  #define GAPA(MF,A0,A1,A2,A3,W0,W1,PW) do{ MF; sacc+=A0; sacc+=A1; sacc+=A2; sacc+=A3; PIN(sacc); W0; W1; PIN(PW); SBAR(); }while(0)
  #define EX(v) __builtin_amdgcn_exp2f(v)
  #define GAPB(MF,X,B) do{ MF; X[B]=EX(X[B]); X[B+1]=EX(X[B+1]); X[B+2]=EX(X[B+2]); X[B+3]=EX(X[B+3]); PIN(X); SBAR(); }while(0)
  #define VRD(i) do{ vlo[i]=vtr(vp_+(((i)>>2)*4096+((i)&3)*1024)); vhi[i]=vtr(vp_+(((i)>>2)*4096+((i)&3)*1024+512)); }while(0)
  #define KRD(G,j) do{ if(G){ kload2(kf,kp0+sl_next,j); SBAR(); } }while(0)
  #define STEP(C0,C1,P0,P1,t,GK,GV,GL) do{ SBAR(); \
    const lds_cptr vp_=vp0+sl_prev; \
    VRD(0); SBAR(); float sacc=(P0[0]+P0[1]); \
    GAPA(C0=__builtin_amdgcn_mfma_f32_32x32x16_bf16(kf[0],qr[0],negm,0,0,0), P0[2],P0[3],P0[4],P0[5],     pw0[0]=PKW(P0,0), pw0[1]=PKW(P0,2), pw0); \
    VRD(4); SBAR(); GAPA(C1=__builtin_amdgcn_mfma_f32_32x32x16_bf16(kf[1],qr[0],negm,0,0,0), P0[6],P0[7],P0[8],P0[9],     pw0[2]=PKW(P0,4), pw0[3]=PKW(P0,6), pw0); \
    VRD(1); SBAR(); GAPA(C0=__builtin_amdgcn_mfma_f32_32x32x16_bf16(kf[2],qr[1],C0,0,0,0),   P0[10],P0[11],P0[12],P0[13], pw1[0]=PKW(P0,8), pw1[1]=PKW(P0,10), pw1); \
    VRD(5); SBAR(); GAPA(C1=__builtin_amdgcn_mfma_f32_32x32x16_bf16(kf[3],qr[1],C1,0,0,0),   P0[14],P0[15],P1[0],P1[1],   pw1[2]=PKW(P0,12),pw1[3]=PKW(P0,14), pw1); \
    VRD(2); SBAR(); GAPA(C0=__builtin_amdgcn_mfma_f32_32x32x16_bf16(kf[4],qr[2],C0,0,0,0),   P1[2],P1[3],P1[4],P1[5],     pw2[0]=PKW(P1,0), pw2[1]=PKW(P1,2), pw2); \
    VRD(6); SBAR(); GAPA(C1=__builtin_amdgcn_mfma_f32_32x32x16_bf16(kf[5],qr[2],C1,0,0,0),   P1[6],P1[7],P1[8],P1[9],     pw2[2]=PKW(P1,4), pw2[3]=PKW(P1,6), pw2); \
    VRD(3); SBAR(); GAPA(C0=__builtin_amdgcn_mfma_f32_32x32x16_bf16(kf[6],qr[3],C0,0,0,0),   P1[10],P1[11],P1[12],P1[13], pw3[0]=PKW(P1,8), pw3[1]=PKW(P1,10), pw3); \
    VRD(7); SBAR(); GAPA(C1=__builtin_amdgcn_mfma_f32_32x32x16_bf16(kf[7],qr[3],C1,0,0,0),   P1[14],P1[15],0.f,0.f,       pw3[2]=PKW(P1,12),pw3[3]=PKW(P1,14), pw3); \
    l_reg+=sacc; \
    if(GK){DMA_K((t)+3,sl_cur);} if(GV){DMA_V((t)+1,sl_next);} \
    CMASK(C0,C1,t); \
    { float a=MX3(C0[0],C0[1],C1[0]),b=MX3(C0[2],C0[3],C1[1]); a=MX3(a,C1[2],C1[3]); \
      _Pragma("unroll") for(int r=4;r<16;r+=4){a=MX3(a,C0[r],C0[r+1]);b=MX3(b,C0[r+2],C0[r+3]);a=MX3(a,C1[r],C1[r+1]);b=MX3(b,C1[r+2],C1[r+3]);} \
      float rm=__builtin_fmaxf(a,b); { auto rr=__builtin_amdgcn_permlane32_swap(__float_as_uint(rm),__float_as_uint(rm),false,false); rm=__builtin_fmaxf(__uint_as_float(rr[0]),__uint_as_float(rr[1])); } \
      resc=false; \
      if(__builtin_expect(__any(rm>(float)THRL),0)){ const float dl=__builtin_fmaxf(rm,0.f); mhat+=dl; \
        _Pragma("unroll") for(int r=0;r<16;++r){C0[r]-=dl;C1[r]-=dl;} \
        _Pragma("unroll") for(int r=0;r<16;++r)negm[r]=-mhat; asm volatile("":"+v"(negm)); \
        const float f=__builtin_amdgcn_exp2f(-dl); l_reg*=f; if(hi==0)wsf[r32]=f; resc=true; } } \
    SBAR(); \
    GAPB(o[0]=__builtin_amdgcn_mfma_f32_32x32x16_bf16(PAF(0),VFR(0),o[0],0,0,0), C0,0); \
    GAPB(o[1]=__builtin_amdgcn_mfma_f32_32x32x16_bf16(PAF(0),VFR(4),o[1],0,0,0), C0,4); \
    KRD(GL,0); GAPB(o[0]=__builtin_amdgcn_mfma_f32_32x32x16_bf16(PAF(1),VFR(1),o[0],0,0,0), C0,8); \
    KRD(GL,1); GAPB(o[1]=__builtin_amdgcn_mfma_f32_32x32x16_bf16(PAF(1),VFR(5),o[1],0,0,0), C0,12); \
    KRD(GL,2); GAPB(o[0]=__builtin_amdgcn_mfma_f32_32x32x16_bf16(PAF(2),VFR(2),o[0],0,0,0), C1,0); \
    KRD(GL,3); GAPB(o[1]=__builtin_amdgcn_mfma_f32_32x32x16_bf16(PAF(2),VFR(6),o[1],0,0,0), C1,4); \
    GAPB(o[0]=__builtin_amdgcn_mfma_f32_32x32x16_bf16(PAF(3),VFR(3),o[0],0,0,0), C1,8); \
    GAPB(o[1]=__builtin_amdgcn_mfma_f32_32x32x16_bf16(PAF(3),VFR(7),o[1],0,0,0), C1,12); \
    }while(0)
  int t=1;
  #undef CMASK
  #define CMASK(P0,P1,t) do{}while(0)
  for(;t+5<NT;t+=2){
    STEP(pB0,pB1,pA0,pA1,t,true,true,true);     WAIT_BAR(2); RESC(); ROT();
    STEP(pA0,pA1,pB0,pB1,t+1,true,true,true);   WAIT_BAR(2); RESC(); ROT();
  }
  #undef CMASK
  #define CMASK(P0,P1,t) do{int jb_=(t)-(NT-4); if(jb_>=0)cmask(P0,P1,jb_,qrel,hi);}while(0)
  #define ENDW(tt) do{ if((tt)+3<NT){WAIT_BAR(2);} else if((tt)+2<NT){WAIT_BAR(1);} else {WAIT_BAR(0);} }while(0)
  for(;t+1<NT;t+=2){
    STEP(pB0,pB1,pA0,pA1,t,(t+3<NT),(t+1<NT),(t+1<NT));       ENDW(t);   RESC(); ROT();
    STEP(pA0,pA1,pB0,pB1,t+1,(t+4<NT),(t+2<NT),(t+2<NT));     ENDW(t+1); RESC(); ROT();
  }
  STEP(pB0,pB1,pA0,pA1,NT-1,false,false,false); RESC();
  { float sacc=pB0[0]+pB0[1]; _Pragma("unroll") for(int r=2;r<16;++r)sacc+=pB0[r]; _Pragma("unroll") for(int r=0;r<16;++r)sacc+=pB1[r]; l_reg+=sacc;
    pw0=(u32x4){PKW(pB0,0),PKW(pB0,2),PKW(pB0,4),PKW(pB0,6)};pw1=(u32x4){PKW(pB0,8),PKW(pB0,10),PKW(pB0,12),PKW(pB0,14)};pw2=(u32x4){PKW(pB1,0),PKW(pB1,2),PKW(pB1,4),PKW(pB1,6)};pw3=(u32x4){PKW(pB1,8),PKW(pB1,10),PKW(pB1,12),PKW(pB1,14)};
    SBAR(); pv(o,vb0+sl_cur,PAF(0),PAF(1),PAF(2),PAF(3)); }
  #undef PKW
  #undef PAF
  #undef VFR
  #undef PIN
  #undef MX3
  #undef GAPA
  #undef GAPB
  #undef EX
  #undef VRD
  #undef KRD
  #undef STEP
  #undef ENDW
  {auto rr=__builtin_amdgcn_permlane32_swap(__float_as_uint(l_reg),__float_as_uint(l_reg),false,false);l_reg=__uint_as_float(rr[0])+__uint_as_float(rr[1]);}
  if(hi==0)wsf[32+r32]=l_reg;asm volatile("s_waitcnt lgkmcnt(0)":::"memory");
  float rli[16];
  #pragma unroll
  for(int r=0;r<16;++r)rli[r]=__builtin_amdgcn_rcpf(wsf[32+crow(r,hi)]);
  bf16*Ow=O+(rowbase+q0+wid*QBLK)*OPITCH;
  { bf16*stg=(bf16*)(shm+LDS_OST)+wid*2048;
    #pragma unroll
    for(int r=0;r<16;++r){const int orow=crow(r,hi);
      #pragma unroll
      for(int d0=0;d0<2;++d0)stg[orow*64+d0*32+r32]=__float2bfloat16(o[d0][r]*rli[r]);}
    asm volatile("s_waitcnt lgkmcnt(0)":::"memory");
    #pragma unroll
    for(int i=0;i<4;++i){const int row=i*8+(lane>>3),ch=lane&7; const u32x4 v=*(const u32x4*)(stg+row*64+ch*8); ATTN_STORE16(Ow+(long)row*OPITCH+ch*8,v);} }
  asm volatile("s_waitcnt lgkmcnt(0)\n\ts_barrier":::"memory");
  #undef DMA_K
  #undef DMA_V
  #undef CMASK
  #undef START
  #undef RESC
  #undef ROT
}
constexpr int ATTN_LDS_BYTES=LDS_BYTES;
#undef SBAR
#undef WAIT_BAR
}
#define LAS __attribute__((address_space(3)))
typedef unsigned short bf16;
typedef unsigned u32x4 __attribute__((ext_vector_type(4)));
typedef unsigned u32x2 __attribute__((ext_vector_type(2)));
typedef float f32x4 __attribute__((ext_vector_type(4)));
typedef float f32x2 __attribute__((ext_vector_type(2)));
typedef float f32x16 __attribute__((ext_vector_type(16)));
typedef short bf16x8 __attribute__((ext_vector_type(8)));
typedef __bf16 bf16x2_t __attribute__((ext_vector_type(2)));

constexpr int NWAVES = 8, NTHR = 512;
constexpr int MT = 16384, DMOD = 2048, SEQL = 4096, IN0W = 7168;
constexpr float EPS = 1e-6f;
constexpr size_t MiB = 1u << 20;
constexpr size_t WS_LAM32 = 64 * 1024;
constexpr size_t WS_ROT = 1 * MiB;
constexpr size_t WS_WIN0 = 2 * MiB, WS_WOUT0 = 30 * MiB, WS_WIN1 = 38 * MiB, WS_WGLU = 54 * MiB, WS_WOUT1 = 62 * MiB;
constexpr size_t WS_TF = 70 * MiB, WS_WF = 74 * MiB, WS_VF = 90 * MiB;
constexpr size_t WS_H = 112 * MiB;
constexpr size_t WS_PROJ = 176 * MiB;
constexpr size_t WS_UGM = 176 * MiB, WS_GATE = 240 * MiB, WS_Z = 304 * MiB;
constexpr size_t WS_CAT = 400 * MiB;
constexpr size_t WS_OUT2 = 432 * MiB, WS_END = 496 * MiB;
constexpr int RING_BYTES = 131072, LDS_BYTES = 147456;
constexpr int NPH = 11;

__device__ __forceinline__ unsigned pkbf(float lo, float hi) { f32x2 v = {lo, hi}; bf16x2_t b = __builtin_convertvector(v, bf16x2_t); return __builtin_bit_cast(unsigned, b); }
__device__ __forceinline__ float bflo(unsigned u) { return __uint_as_float(u << 16); }
__device__ __forceinline__ float bfhi(unsigned u) { return __uint_as_float(u & 0xffff0000u); }
__device__ __forceinline__ float sigm(float x) { return __builtin_amdgcn_rcpf(1.0f + __expf(-x)); }
__device__ __forceinline__ float siluf(float x) { return x * sigm(x); }
__device__ __forceinline__ float gelu_tanh(float x) { return x * sigm(1.5957691216057308f * (x + 0.044715f * x * x * x)); }
__device__ __forceinline__ float wave_sum(float v) {
#pragma unroll
    for (int o = 1; o < 64; o <<= 1) v += __shfl_xor(v, o);
    return v;
}
__device__ __forceinline__ int crow(int r, int hi) { return (r & 3) + 8 * (r >> 2) + 4 * hi; }
__device__ __forceinline__ float red_angle(double th) { const double rev = th * 0.15915494309189535; const double fr = rev - rint(rev); return (float)(fr * 6.283185307179586); }

typedef __attribute__((address_space(1))) unsigned gu32;
#define XB_TMO      128
#define XB_XCNT(j)  (256  + 64 * (j))
#define XB_XSUB(j)  (1280 + 64 * (j))
#define XB_XGEN(j)  (2304 + 64 * (j))
#define XB_TOP      3328
#define XB_TOPGEN   3392
#define XCD_BAR_WORDS 3456
#define XB_SPIN_CAP (1u << 18)

__device__ __forceinline__ unsigned xb_ld(unsigned* p)              { return __hip_atomic_load(p, __ATOMIC_RELAXED, __HIP_MEMORY_SCOPE_AGENT); }
__device__ __forceinline__ unsigned xb_add(unsigned* p, unsigned v) { return __hip_atomic_fetch_add(p, v, __ATOMIC_RELAXED, __HIP_MEMORY_SCOPE_AGENT); }
__device__ __forceinline__ unsigned xb_xcc_id() { return (unsigned)__builtin_amdgcn_s_getreg((3 << 11) | 20) & 0xFu; }
#define XB_SPIN(cond, bar) do { unsigned _sp = 0; while (cond) { __builtin_amdgcn_s_sleep(1); \
    if ((++_sp & 255u) == 0u) { if (xb_ld(&(bar)[XB_TMO])) break; if (_sp > XB_SPIN_CAP) { atomicAdd(&(bar)[XB_TMO], 1u); break; } } } } while (0)

struct XcdBarrier {
    unsigned* bar; unsigned x;
    volatile LAS unsigned* st;
};

__device__ __forceinline__ XcdBarrier xcd_barrier_post(unsigned* bar, volatile LAS unsigned* st) {
    XcdBarrier b; b.bar = bar; b.x = xb_xcc_id(); b.st = st;
    if (threadIdx.x == 0) (void)xb_add(&bar[XB_XCNT(b.x)], 1u);
    return b;
}
__device__ __forceinline__ void xcd_barrier_complete(unsigned* bar, unsigned x, unsigned& nloc, unsigned& nx) {
    const unsigned G = gridDim.x * gridDim.y * gridDim.z;
    unsigned sum, cnt, mine, sp = 0u;
    for (;;) {
        sum = 0u; cnt = 0u; mine = 0u;
#pragma unroll
        for (unsigned j = 0; j < 16; ++j) { const unsigned c = xb_ld(&bar[XB_XCNT(j)]); sum += c; cnt += (c > 0u) ? 1u : 0u; mine = (j == x) ? c : mine; }
        if (sum == G) break;
        __builtin_amdgcn_s_sleep(1);
        if ((++sp & 255u) == 0u) { if (xb_ld(&bar[XB_TMO])) break; if (sp > XB_SPIN_CAP) { atomicAdd(&bar[XB_TMO], 1u); break; } }
    }
    nloc = mine > 0u ? mine : 1u; nx = cnt > 0u ? cnt : 1u;
}

__device__ __forceinline__ void xcd_barrier(const XcdBarrier& b) {
    asm volatile("s_waitcnt vmcnt(0)" ::: "memory");
    __syncthreads();
    if (threadIdx.x == 0) {
        unsigned* bar = b.bar;
        __builtin_amdgcn_s_waitcnt(0);
        unsigned nloc = b.st[0], nx = b.st[1];
        if (nloc == 0u) { xcd_barrier_complete(bar, b.x, nloc, nx); b.st[0] = nloc; b.st[1] = nx; }
        const unsigned old = xb_add(&bar[XB_XSUB(b.x)], 1u);
        const unsigned gen = old / nloc;
        if (old + 1u == (gen + 1u) * nloc) {
            __builtin_amdgcn_fence(__ATOMIC_RELEASE, "agent");
            asm volatile("s_waitcnt vmcnt(0)" ::: "memory");
            const unsigned og = xb_add(&bar[XB_TOP], 1u);
            const unsigned tg = og / nx;
            if (og + 1u == (tg + 1u) * nx) xb_add(&bar[XB_TOPGEN], 1u);
            else XB_SPIN(xb_ld(&bar[XB_TOPGEN]) == tg, bar);
            __builtin_amdgcn_fence(__ATOMIC_ACQUIRE, "agent");
            xb_add(&bar[XB_XGEN(b.x)], 1u);
            asm volatile("s_waitcnt vmcnt(0)" ::: "memory");
        } else {
            XB_SPIN(xb_ld(&bar[XB_XGEN(b.x)]) == gen, bar);
            __builtin_amdgcn_fence(__ATOMIC_ACQUIRE, "agent");
            asm volatile("s_waitcnt vmcnt(0)" ::: "memory");
        }
    }
    __syncthreads();
}

struct Args { const float* in[28]; float* out; unsigned char* ws; int ph_lo, ph_hi; };

__device__ __forceinline__ void p0_transpose_item(const float* W, int K, int N, bf16* WT, LAS float* scr, int item, int lane) {
    const int nblk = N / 32, kb = item / nblk, nb = item % nblk, k0 = 64 * kb, n0 = 32 * nb;
#pragma unroll 8
    for (int i = 0; i < 32; ++i) { const int kk = 2 * i + (lane >> 5); scr[kk * 33 + (lane & 31)] = W[(size_t)(k0 + kk) * N + n0 + (lane & 31)]; }
    asm volatile("s_waitcnt lgkmcnt(0)" ::: "memory");
    const int c = lane & 7;
#pragma unroll
    for (int j = 0; j < 4; ++j) { const int n = (lane >> 3) + 8 * j; const LAS float* s = scr + (8 * c) * 33 + n;
        u32x4 o; o.x = pkbf(s[0 * 33], s[1 * 33]); o.y = pkbf(s[2 * 33], s[3 * 33]); o.z = pkbf(s[4 * 33], s[5 * 33]); o.w = pkbf(s[6 * 33], s[7 * 33]);
        *(u32x4*)(WT + (size_t)(n0 + n) * K + k0 + 8 * c) = o; }
    asm volatile("s_waitcnt lgkmcnt(0)" ::: "memory");
}
__device__ __forceinline__ void rms_row_to_bf16(const float* xrow, const float* g, bf16* orow, int lane) {
    const f32x4* xr = (const f32x4*)xrow + lane; const f32x4* gr = (const f32x4*)g + lane;
    f32x4 v[8]; float s = 0.f;
#pragma unroll
    for (int j = 0; j < 8; ++j) { v[j] = xr[64 * j]; s += (v[j].x * v[j].x + v[j].y * v[j].y) + (v[j].z * v[j].z + v[j].w * v[j].w); }
    const float r = 1.0f / sqrtf(wave_sum(s) * (1.0f / DMOD) + EPS);
    u32x2* o8 = (u32x2*)orow + lane;
#pragma unroll
    for (int j = 0; j < 8; ++j) { const f32x4 gg = gr[64 * j]; u32x2 w; w.x = pkbf(v[j].x * r * gg.x, v[j].y * r * gg.y); w.y = pkbf(v[j].z * r * gg.z, v[j].w * r * gg.w); o8[64 * j] = w; }
}
__device__ __forceinline__ void s5_tables(const Args& a, LAS unsigned char* lds, int g, int tid) {
    LAS float* POWr = (LAS float*)lds;
    LAS float* POWi = POWr + 33 * 64;
    LAS float* BBr = POWi + 33 * 64;
    LAS float* BBi = BBr + 1024;
    LAS float* Cr = BBi + 1024;
    LAS float* Ci = Cr + 1024;
    LAS float* KL = Ci + 1024;
    const float* a_re = a.in[17] + g * 64; const float* a_im = a.in[18] + g * 64;
    const float dt = expf(a.in[19][g]);
    for (int idx = tid; idx < 33 * 64; idx += NTHR) { const int k = idx >> 6, p = idx & 63;
        const float ar = a_re[p], ai = a_im[p]; const float mag = expf(ar * dt * (float)k);
        const float ang = red_angle((double)ai * (double)dt * (double)k);
        POWr[idx] = mag * cosf(ang); POWi[idx] = mag * sinf(ang); }
    for (int idx = tid; idx < 1024; idx += NTHR) { const int p = idx >> 4;
        const float ar = a_re[p], ai = a_im[p];
        const float em1 = expm1f(ar * dt); const float ang = red_angle((double)ai * (double)dt);
        const float sn = sinf(ang), cs = cosf(ang), sh = sinf(0.5f * ang);
        const float nr = em1 * cs - 2.0f * sh * sh, ni = (em1 + 1.0f) * sn;
        const float den = ar * ar + ai * ai; const float fr = (nr * ar + ni * ai) / den, fi = (ni * ar - nr * ai) / den;
        const float br = a.in[20][(size_t)g * 1024 + idx], bi = a.in[21][(size_t)g * 1024 + idx];
        BBr[idx] = fr * br - fi * bi; BBi[idx] = fr * bi + fi * br;
        Cr[idx] = a.in[22][(size_t)g * 1024 + idx]; Ci[idx] = a.in[23][(size_t)g * 1024 + idx]; }
    __syncthreads();
    {
        const int lag = tid >> 4, m = tid & 15; float acc[16];
#pragma unroll
        for (int q = 0; q < 16; ++q) acc[q] = 0.f;
        for (int p = 0; p < 64; ++p) { const float cr = Cr[m * 64 + p], ci = Ci[m * 64 + p], pr = POWr[lag * 64 + p], pi = POWi[lag * 64 + p];
            const float gr = cr * pr - ci * pi, gi = cr * pi + ci * pr;
#pragma unroll
            for (int q = 0; q < 16; ++q) acc[q] += gr * BBr[p * 16 + q] - gi * BBi[p * 16 + q]; }
#pragma unroll
        for (int q = 0; q < 16; ++q) KL[(lag * 16 + m) * 16 + q] = acc[q];
    }
    __syncthreads();
    bf16* TF = (bf16*)(a.ws + WS_TF) + (size_t)g * 32 * 64 * 8;
    for (int idx = tid; idx < 32 * 64; idx += NTHR) { const int dd = idx >> 6, lane = idx & 63, n = lane & 31, kh = lane >> 5; const int lag = dd - 1 + (n >> 4), m = n & 15;
        float v[8];
#pragma unroll
        for (int j = 0; j < 8; ++j) v[j] = (lag >= 0 && lag < 32) ? KL[(lag * 16 + m) * 16 + 8 * kh + j] : 0.f;
        u32x4 w; w.x = pkbf(v[0], v[1]); w.y = pkbf(v[2], v[3]); w.z = pkbf(v[4], v[5]); w.w = pkbf(v[6], v[7]);
        *(u32x4*)(TF + (size_t)idx * 8) = w; }
    bf16* WF = (bf16*)(a.ws + WS_WF) + (size_t)g * 32 * 4 * 64 * 8;
    for (int idx = tid; idx < 32 * 4 * 64; idx += NTHR) { const int sp = idx >> 8, nt = (idx >> 6) & 3, lane = idx & 63, n = lane & 31, kh = lane >> 5;
        const int pp = 32 * nt + n, p = pp & 63, comp = pp >> 6, k = 31 - sp; const float pr = POWr[k * 64 + p], pi = POWi[k * 64 + p];
        float v[8];
#pragma unroll
        for (int j = 0; j < 8; ++j) { const float br = BBr[p * 16 + 8 * kh + j], bi = BBi[p * 16 + 8 * kh + j]; v[j] = comp ? (pr * bi + pi * br) : (pr * br - pi * bi); }
        u32x4 w; w.x = pkbf(v[0], v[1]); w.y = pkbf(v[2], v[3]); w.z = pkbf(v[4], v[5]); w.w = pkbf(v[6], v[7]);
        *(u32x4*)(WF + (size_t)idx * 8) = w; }
    bf16* VF = (bf16*)(a.ws + WS_VF) + (size_t)g * 16 * 8 * 64 * 8;
    for (int idx = tid; idx < 16 * 8 * 64; idx += NTHR) { const int jt = idx >> 9, kk = (idx >> 6) & 7, lane = idx & 63, n = lane & 31, kh = lane >> 5;
        const int s = 2 * jt + (n >> 4), m = n & 15;
        float v[8];
#pragma unroll
        for (int j = 0; j < 8; ++j) { const int pp = 16 * kk + 8 * kh + j, p = pp & 63, comp = pp >> 6;
            const float pr = POWr[(s + 1) * 64 + p], pi = POWi[(s + 1) * 64 + p], cr = Cr[m * 64 + p], ci = Ci[m * 64 + p];
            v[j] = comp ? -(cr * pi + ci * pr) : (cr * pr - ci * pi); }
        u32x4 w; w.x = pkbf(v[0], v[1]); w.y = pkbf(v[2], v[3]); w.z = pkbf(v[4], v[5]); w.w = pkbf(v[6], v[7]);
        *(u32x4*)(VF + (size_t)idx * 8) = w; }
    if (tid < 64) { f32x2* L = (f32x2*)(a.ws + WS_LAM32) + g * 64 + tid; *L = (f32x2){POWr[32 * 64 + tid], POWi[32 * 64 + tid]}; }
    __syncthreads();
}

__device__ __forceinline__ void p0_prologue(const Args& a, LAS unsigned char* lds, int tid, int lane, int wave, int G) {
    for (int g = blockIdx.x; g < 128; g += G) s5_tables(a, lds, g, tid);
    {
        f32x2* ROT = (f32x2*)(a.ws + WS_ROT);
        for (int idx = blockIdx.x * NTHR + tid; idx < SEQL * 32; idx += G * NTHR) { const int pos = idx >> 5, i = idx & 31;
            const float freq = exp2f(-(float)i * (13.287712379549449f / 32.0f));
            const float ang = red_angle((double)pos * (double)freq);
            ROT[idx] = (f32x2){cosf(ang), sinf(ang)}; }
    }
    LAS float* scr = (LAS float*)(lds + wave * 16384);
    const int gw = blockIdx.x * NWAVES + wave, NGW = G * NWAVES;
    constexpr int I0 = 32 * (IN0W / 32), I1 = 32 * (2048 / 32), I2 = 32 * (4096 / 32);
    constexpr int NITEMS = I0 + I1 + I2 + I1 + I1;
    for (int it = gw; it < NITEMS; it += NGW) {
        int r = it;
        if (r < I0) { p0_transpose_item(a.in[2], 2048, IN0W, (bf16*)(a.ws + WS_WIN0), scr, r, lane); continue; } r -= I0;
        if (r < I1) { p0_transpose_item(a.in[14], 2048, 2048, (bf16*)(a.ws + WS_WOUT0), scr, r, lane); continue; } r -= I1;
        if (r < I2) { p0_transpose_item(a.in[16], 2048, 4096, (bf16*)(a.ws + WS_WIN1), scr, r, lane); continue; } r -= I2;
        if (r < I1) { p0_transpose_item(a.in[25], 2048, 2048, (bf16*)(a.ws + WS_WGLU), scr, r, lane); continue; } r -= I1;
        p0_transpose_item(a.in[27], 2048, 2048, (bf16*)(a.ws + WS_WOUT1), scr, r, lane);
    }
    for (int m = gw; m < MT; m += NGW) rms_row_to_bf16(a.in[0] + (size_t)m * DMOD, a.in[1], (bf16*)(a.ws + WS_H) + (size_t)m * DMOD, lane);
}

__device__ __forceinline__ void mixer_a_unit(const Args& a, LAS unsigned char* lds, int unit, int tid, int lane, int wave) {
    const int t0 = unit * 32, s0 = t0 & (SEQL - 1);
    const bf16* PROJ = (const bf16*)(a.ws + WS_PROJ);
    for (int idx = tid; idx < 62 * 128; idx += NTHR) { const int r = idx >> 7, ch = (idx & 127) * 8; u32x4 w = {0u, 0u, 0u, 0u};
        if (s0 - 30 + r >= 0) { const bf16* row = PROJ + (size_t)(t0 - 30 + r) * IN0W + ch; const u32x4 av = *(const u32x4*)row, gl = *(const u32x4*)(row + 1024);
#pragma unroll
            for (int q = 0; q < 4; ++q) w[q] = pkbf(bflo(av[q]) * sigm(bflo(gl[q])), bfhi(av[q]) * sigm(bfhi(gl[q]))); }
        *(LAS u32x4*)(lds + r * 2048 + ch * 2) = w; }
    __syncthreads();
    {
        f32x2 P[31], w[31];
        const f32x2 cb = *(const f32x2*)(a.in[4] + 2 * tid);
#pragma unroll
        for (int j = 0; j < 31; ++j) { P[j] = cb; w[j] = *(const f32x2*)(a.in[3] + j * 1024 + 2 * tid); }
#define CROW(RHO) { const int r = q * 31 + (RHO); const unsigned uw = *(const LAS unsigned*)(lds + r * 2048 + tid * 4); const f32x2 uv = {bflo(uw), bfhi(uw)}; \
        _Pragma("unroll") for (int j = 0; j < 31; ++j) P[((RHO) - j + 31) % 31] += w[j] * uv; \
        if (r >= 30) *(LAS unsigned*)(lds + (r - 30) * 2048 + tid * 4) = pkbf(P[((RHO) + 1) % 31].x, P[((RHO) + 1) % 31].y); \
        P[((RHO) + 1) % 31] = cb; }
#pragma unroll 1
        for (int q = 0; q < 2; ++q) {
            CROW(0) CROW(1) CROW(2) CROW(3) CROW(4) CROW(5) CROW(6) CROW(7) CROW(8) CROW(9) CROW(10) CROW(11) CROW(12) CROW(13) CROW(14) CROW(15)
            CROW(16) CROW(17) CROW(18) CROW(19) CROW(20) CROW(21) CROW(22) CROW(23) CROW(24) CROW(25) CROW(26) CROW(27) CROW(28) CROW(29) CROW(30)
        }
#undef CROW
    }
    __syncthreads();
    bf16* CAT = (bf16*)(a.ws + WS_CAT);
#pragma unroll 1
    for (int q = 0; q < 4; ++q) { const int i = wave * 4 + q; float v[16]; float s = 0.f;
#pragma unroll
        for (int j = 0; j < 2; ++j) { const u32x4 cw = *(const LAS u32x4*)(lds + i * 2048 + (512 * j + lane * 8) * 2);
#pragma unroll
            for (int e = 0; e < 4; ++e) { v[8 * j + 2 * e] = bflo(cw[e]); v[8 * j + 2 * e + 1] = bfhi(cw[e]); } }
#pragma unroll
        for (int e = 0; e < 16; ++e) s += v[e];
        const float mean = wave_sum(s) * (1.0f / 1024.0f); float s2 = 0.f;
#pragma unroll
        for (int e = 0; e < 16; ++e) { v[e] -= mean; s2 += v[e] * v[e]; }
        const float rstd = 1.0f / sqrtf(wave_sum(s2) * (1.0f / 1024.0f) + EPS);
        const size_t row = (size_t)(t0 + i);
#pragma unroll
        for (int j = 0; j < 2; ++j) { const int col = 512 * j + lane * 8;
            const f32x4 g0 = *(const f32x4*)(a.in[5] + col), g1 = *(const f32x4*)(a.in[5] + col + 4), b0 = *(const f32x4*)(a.in[6] + col), b1 = *(const f32x4*)(a.in[6] + col + 4);
            const u32x4 gt = *(const u32x4*)(PROJ + row * IN0W + 2048 + col);
            const float gg[8] = {g0.x, g0.y, g0.z, g0.w, g1.x, g1.y, g1.z, g1.w}, bb[8] = {b0.x, b0.y, b0.z, b0.w, b1.x, b1.y, b1.z, b1.w};
            u32x4 o;
#pragma unroll
            for (int e = 0; e < 4; ++e) { const float y0 = v[8 * j + 2 * e] * rstd * gg[2 * e] + bb[2 * e], y1 = v[8 * j + 2 * e + 1] * rstd * gg[2 * e + 1] + bb[2 * e + 1];
                o[e] = pkbf(siluf(y0) * siluf(bflo(gt[e])), siluf(y1) * siluf(bfhi(gt[e]))); }
            *(u32x4*)(CAT + row * DMOD + col) = o; } }
    __syncthreads();
}
__device__ __forceinline__ void qk_prep_item(const Args& a, int item, int lane) {
    const int row = item >> 1, which = item & 1, pos = row & (SEQL - 1);
    bf16* base = (bf16*)(a.ws + WS_PROJ) + (size_t)row * IN0W + 3072 + which * 1024 + (lane >> 2) * 64 + (lane & 3) * 8;
    const int i0 = (lane & 3) * 8;
    const u32x4 x1 = *(const u32x4*)base, x2 = *(const u32x4*)(base + 32);
    float f1[8], f2[8]; float ss = 0.f;
#pragma unroll
    for (int q = 0; q < 4; ++q) { f1[2 * q] = bflo(x1[q]); f1[2 * q + 1] = bfhi(x1[q]); f2[2 * q] = bflo(x2[q]); f2[2 * q + 1] = bfhi(x2[q]); }
#pragma unroll
    for (int j = 0; j < 8; ++j) ss += f1[j] * f1[j] + f2[j] * f2[j];
    ss += __shfl_xor(ss, 1); ss += __shfl_xor(ss, 2);
    const float sc = (1.0f / sqrtf(ss * (1.0f / 64.0f) + EPS)) * (which == 0 ? 0.125f * 1.4426950408889634f : 1.0f);
    const float* g = (which == 0 ? a.in[7] : a.in[8]);
    const f32x2* rot = (const f32x2*)(a.ws + WS_ROT) + pos * 32 + i0;
    float o1[8], o2[8];
#pragma unroll
    for (int j = 0; j < 8; ++j) { const float y1 = f1[j] * sc * g[i0 + j], y2 = f2[j] * sc * g[32 + i0 + j]; const f32x2 cs = rot[j];
        o1[j] = y1 * cs.x - y2 * cs.y; o2[j] = y2 * cs.x + y1 * cs.y; }
    u32x4 w1, w2;
#pragma unroll
    for (int q = 0; q < 4; ++q) { w1[q] = pkbf(o1[2 * q], o1[2 * q + 1]); w2[q] = pkbf(o2[2 * q], o2[2 * q + 1]); }
    *(u32x4*)base = w1; *(u32x4*)(base + 32) = w2;
}
__device__ __forceinline__ void combine_item(const Args& a, int item, int lane, float lam) {
    const int row = item >> 1, hg = item & 1, h = hg * 4 + (lane >> 4), j0 = (lane & 15) * 8;
    const bf16* OP = (const bf16*)(a.ws + WS_H) + (size_t)row * DMOD + h * 128 + j0;
    const u32x4 a0 = *(const u32x4*)OP, a1 = *(const u32x4*)(OP + 1024);
    const u32x4 bg = *(const u32x4*)((const bf16*)(a.ws + WS_PROJ) + (size_t)row * IN0W + 6144 + h * 128 + j0);
    float o[8]; float ss = 0.f;
#pragma unroll
    for (int q = 0; q < 4; ++q) { o[2 * q] = bflo(a0[q]) - lam * bflo(a1[q]); o[2 * q + 1] = bfhi(a0[q]) - lam * bfhi(a1[q]); }
#pragma unroll
    for (int j = 0; j < 8; ++j) ss += o[j] * o[j];
    ss += __shfl_xor(ss, 1); ss += __shfl_xor(ss, 2); ss += __shfl_xor(ss, 4); ss += __shfl_xor(ss, 8);
    const float r = (1.0f / sqrtf(ss * (1.0f / 128.0f) + EPS)) * 0.8f;
    const float* sg = a.in[13] + j0;
    u32x4 w;
#pragma unroll
    for (int q = 0; q < 4; ++q) w[q] = pkbf(o[2 * q] * r * sg[2 * q] * siluf(bflo(bg[q])), o[2 * q + 1] * r * sg[2 * q + 1] * siluf(bfhi(bg[q])));
    *(u32x4*)((bf16*)(a.ws + WS_CAT) + (size_t)row * DMOD + 1024 + h * 128 + j0) = w;
}

constexpr int UPITCH = 1040, HPITCH = 272, S5_UIMG = 0, S5_HIMG = 64 * UPITCH, S5_EBUF = S5_HIMG + 64 * HPITCH;
__device__ __forceinline__ void s5_item(const Args& a, LAS unsigned char* lds, int item, int tid, int lane, int wave) {
    const int g = item & 127, b = item >> 7, r32 = lane & 31, hi = lane >> 5;
    const bf16* Ugm = (const bf16*)(a.ws + WS_UGM) + ((size_t)g * MT + (size_t)b * SEQL) * 16;
    const bf16x8* TF = (const bf16x8*)(a.ws + WS_TF) + (size_t)g * 32 * 64 + lane;
    const bf16x8* WF = (const bf16x8*)(a.ws + WS_WF) + (size_t)g * 32 * 4 * 64 + lane;
    const bf16x8* VF = (const bf16x8*)(a.ws + WS_VF) + (size_t)g * 16 * 8 * 64 + lane;
    bf16* Z = (bf16*)(a.ws + WS_Z);
    const float dsk = a.in[24][g * 16 + (r32 & 15)];
    float hr = 0.f, him = 0.f; f32x2 l32 = {0.f, 0.f};
    if (wave == 0) l32 = ((const f32x2*)(a.ws + WS_LAM32))[g * 64 + lane];
#pragma unroll 1
    for (int half = 0; half < 2; ++half) {
        {
            const u32x4* src = (const u32x4*)(Ugm + (size_t)half * 2048 * 16);
#pragma unroll
            for (int ps = 0; ps < 8; ++ps) { const int idx = ps * NTHR + tid; const u32x4 v = src[idx]; *(LAS u32x4*)(lds + S5_UIMG + (idx >> 6) * UPITCH + (idx & 63) * 16) = v; }
        }
        __syncthreads();
        {
            const int mt = wave >> 2, nt = wave & 3; f32x16 acc = {};
            const LAS unsigned char* ap = lds + S5_UIMG + (32 * mt + r32) * UPITCH + hi * 16;
#pragma unroll 8
            for (int sp = 0; sp < 32; ++sp) { const bf16x8 A = *(const LAS bf16x8*)(ap + sp * 32); const bf16x8 B = WF[(sp * 4 + nt) * 64];
                acc = __builtin_amdgcn_mfma_f32_32x32x16_bf16(A, B, acc, 0, 0, 0); }
            LAS float* E = (LAS float*)(lds + S5_EBUF);
#pragma unroll
            for (int i = 0; i < 16; ++i) E[(32 * mt + crow(i, hi)) * 128 + 32 * nt + r32] = acc[i];
        }
        __syncthreads();
        if (wave == 0) {
            const LAS float* E = (const LAS float*)(lds + S5_EBUF); LAS bf16* H = (LAS bf16*)(lds + S5_HIMG);
#pragma unroll 8
            for (int c = 0; c < 64; ++c) { const unsigned pk = pkbf(hr, him); H[c * (HPITCH / 2) + lane] = (bf16)(pk & 0xffffu); H[c * (HPITCH / 2) + 64 + lane] = (bf16)(pk >> 16);
                const float er = E[c * 128 + lane], ei = E[c * 128 + 64 + lane];
                const float nr = l32.x * hr - l32.y * him + er, ni = l32.x * him + l32.y * hr + ei; hr = nr; him = ni; }
        }
        __syncthreads();
        f32x16 acc[2][2];
#pragma unroll
        for (int jj = 0; jj < 2; ++jj) { const int j = jj ? 15 - wave : wave; acc[jj][0] = (f32x16){}; acc[jj][1] = (f32x16){};
            const LAS unsigned char* ap = lds + S5_UIMG + r32 * UPITCH + hi * 16; const int nks = 2 * j + 2;
#pragma unroll 4
            for (int sp = 0; sp < nks; ++sp) { const bf16x8 B = TF[(2 * j + 1 - sp) * 64]; const bf16x8 A0 = *(const LAS bf16x8*)(ap + sp * 32), A1 = *(const LAS bf16x8*)(ap + 32 * UPITCH + sp * 32);
                acc[jj][0] = __builtin_amdgcn_mfma_f32_32x32x16_bf16(A0, B, acc[jj][0], 0, 0, 0); acc[jj][1] = __builtin_amdgcn_mfma_f32_32x32x16_bf16(A1, B, acc[jj][1], 0, 0, 0); }
            const LAS unsigned char* hp = lds + S5_HIMG + r32 * HPITCH + hi * 16;
#pragma unroll
            for (int kk = 0; kk < 8; ++kk) { const bf16x8 B = VF[(j * 8 + kk) * 64]; const bf16x8 A0 = *(const LAS bf16x8*)(hp + kk * 32), A1 = *(const LAS bf16x8*)(hp + 32 * HPITCH + kk * 32);
                acc[jj][0] = __builtin_amdgcn_mfma_f32_32x32x16_bf16(A0, B, acc[jj][0], 0, 0, 0); acc[jj][1] = __builtin_amdgcn_mfma_f32_32x32x16_bf16(A1, B, acc[jj][1], 0, 0, 0); }
        }
        __syncthreads();
#pragma unroll
        for (int jj = 0; jj < 2; ++jj) { const int j = jj ? 15 - wave : wave;
#pragma unroll
            for (int mt = 0; mt < 2; ++mt)
#pragma unroll
                for (int i = 0; i < 16; ++i) { LAS bf16* up = (LAS bf16*)(lds + S5_UIMG + (32 * mt + crow(i, hi)) * UPITCH + j * 64 + r32 * 2);
                    const float u = __uint_as_float((unsigned)(*up) << 16); const float v = acc[jj][mt][i] + dsk * u;
                    *up = (bf16)(pkbf(gelu_tanh(v), 0.f) & 0xffffu); } }
        __syncthreads();
#pragma unroll
        for (int ps = 0; ps < 4; ++ps) { const int idx = ps * NTHR + tid; const LAS unsigned char* sp_ = lds + S5_UIMG + (idx >> 5) * UPITCH + (idx & 31) * 32;
            const u32x4 v0 = *(const LAS u32x4*)sp_, v1 = *(const LAS u32x4*)(sp_ + 16);
            bf16* dst = Z + (size_t)(b * SEQL + half * 2048 + idx) * DMOD + 16 * g; *(u32x4*)dst = v0; *(u32x4*)(dst + 8) = v1; }
        __syncthreads();
    }
}

#ifndef MK_N_LAUNCHES
#define MK_N_LAUNCHES 1
#endif
__global__ void __launch_bounds__(NTHR, 2) fwd_kernel(Args a) {
    extern __shared__ __attribute__((aligned(16))) unsigned char lds_raw[];
    cg::grid_group grid = cg::this_grid();
    LAS unsigned char* lds = (LAS unsigned char*)lds_raw;
    const int tid = threadIdx.x, lane = tid & 63, wave = __builtin_amdgcn_readfirstlane(tid >> 6), G = gridDim.x;
    const int bx = blockIdx.x; const int vcu = (G % 8 == 0) ? (bx % 8) * (G / 8) + bx / 8 : bx;
    const int gw = bx * NWAVES + wave, NGW = G * NWAVES;
    const int lo = a.ph_lo, hi = a.ph_hi;
    unsigned char* ws = a.ws;
    volatile LAS unsigned* MISC = (volatile LAS unsigned*)(lds + RING_BYTES + 320);
    if (tid < 32) MISC[tid] = 0u;
    __syncthreads();
    XcdBarrier bar = xcd_barrier_post((unsigned*)ws, MISC + 8);
#define IN(k) (lo <= (k) && (k) < hi)
#define SEAM(k) do { if (IN(k) && IN((k) + 1)) { if ((k) == 0) grid.sync(); else xcd_barrier(bar); } } while (0)

    if (IN(0)) { p0_prologue(a, lds, tid, lane, wave, G); }
    SEAM(0);
    if (IN(1)) {
        pg8::Gemm g{(const bf16*)(ws + WS_H), (const bf16*)(ws + WS_WIN0), MT, IN0W, DMOD}; pg8::StaticOrder S; S.init(MT, IN0W, G, bx);
        pg8::EpiBf16<0> E{(bf16*)(ws + WS_PROJ), IN0W, nullptr, 0, 0, 1.f};
        pg8::gemm_phase<pg8::EpiBf16<0>, pg8::StaticOrder, PG8_ALIGN, PG8_SP2>(lds, g, S, E);
    }
    SEAM(1);
    if (IN(2)) {
        for (int u = bx; u < MT / 32; u += G) mixer_a_unit(a, lds, u, tid, lane, wave);
        for (int it = gw; it < MT * 2; it += NGW) qk_prep_item(a, it, lane);
    }
    SEAM(2);
    if (IN(3)) {
        const attn_body::bf16* PROJ = (const attn_body::bf16*)(ws + WS_PROJ); attn_body::bf16* OP = (attn_body::bf16*)(ws + WS_H);
        const int per = (1024 + G - 1) / G;
#pragma unroll 1
        for (int ui = 0; ui < 2 * per; ++ui) { const int pi = vcu * per + (ui >> 1); if (pi >= 1024) break;
            const int bhv = pi >> 3, s = pi & 7, b = bhv >> 5, hv = bhv & 31, h = hv >> 2, c = (hv >> 1) & 1, vh = hv & 1;
            const attn_body::bf16* Q = PROJ + 3072 + h * 128 + c * 64; const attn_body::bf16* K = PROJ + 4096 + h * 128 + c * 64; const attn_body::bf16* V = PROJ + 5120 + h * 128 + vh * 64;
            attn_body::bf16* O = OP + c * 1024 + h * 128 + vh * 64;
            attn_body::attn_unit<8>(b, (ui & 1) ? 15 - s : s, Q, K, V, O, (char*)lds_raw);
        }
    }
    SEAM(3);
    if (IN(4)) {
        const float p1 = a.in[9][lane] * a.in[10][lane], p2 = a.in[11][lane] * a.in[12][lane];
        const float lam = expf(wave_sum(p1)) - expf(wave_sum(p2)) + 0.2f;
        for (int it = gw; it < MT * 2; it += NGW) combine_item(a, it, lane, lam);
    }
    SEAM(4);
    if (IN(5)) {
        pg8::Gemm g{(const bf16*)(ws + WS_CAT), (const bf16*)(ws + WS_WOUT0), MT, DMOD, DMOD}; pg8::StaticOrder S; S.init(MT, DMOD, G, bx);
        pg8::EpiResF32 E{a.in[0], a.out, DMOD};
        pg8::gemm_phase<pg8::EpiResF32, pg8::StaticOrder, PG8_ALIGN, PG8_SP2>(lds, g, S, E);
    }
    SEAM(5);
    if (IN(6)) { for (int m = gw; m < MT; m += NGW) rms_row_to_bf16(a.out + (size_t)m * DMOD, a.in[15], (bf16*)(ws + WS_H) + (size_t)m * DMOD, lane); }
    SEAM(6);
    if (IN(7)) {
        pg8::Gemm g{(const bf16*)(ws + WS_H), (const bf16*)(ws + WS_WIN1), MT, 4096, DMOD}; pg8::StaticOrder S; S.init(MT, 4096, G, bx);
        pg8::EpiUG E{(bf16*)(ws + WS_UGM), (bf16*)(ws + WS_GATE), MT};
        pg8::gemm_phase<pg8::EpiUG, pg8::StaticOrder, PG8_ALIGN, PG8_SP2>(lds, g, S, E);
    }
    SEAM(7);
    if (IN(8)) { for (int it = bx; it < 512; it += G) s5_item(a, lds, it, tid, lane, wave); }
    SEAM(8);
    if (IN(9)) {
        pg8::Gemm g{(const bf16*)(ws + WS_Z), (const bf16*)(ws + WS_WGLU), MT, DMOD, DMOD}; pg8::StaticOrder S; S.init(MT, DMOD, G, bx);
        pg8::EpiGlu E{(const bf16*)(ws + WS_Z), (const bf16*)(ws + WS_GATE), (bf16*)(ws + WS_OUT2), a.in[26]};
        pg8::gemm_phase<pg8::EpiGlu, pg8::StaticOrder, PG8_ALIGN, PG8_SP2>(lds, g, S, E);
    }
    SEAM(9);
    if (IN(10)) {
        pg8::Gemm g{(const bf16*)(ws + WS_OUT2), (const bf16*)(ws + WS_WOUT1), MT, DMOD, DMOD}; pg8::StaticOrder S; S.init(MT, DMOD, G, bx);
        pg8::EpiResF32 E{a.out, a.out, DMOD};
        pg8::gemm_phase<pg8::EpiResF32, pg8::StaticOrder, PG8_ALIGN, PG8_SP2>(lds, g, S, E);
    }
#undef IN
#undef SEAM
}

extern "C" void kernel_launch(void* const* d_in, const int* in_sizes, int n_in, void* d_out, int out_size, void* d_ws, size_t ws_size, hipStream_t stream) {
    static int grid = 0;
    if (grid == 0) {
        if (n_in != 28 || in_sizes[0] != MT * DMOD || out_size != MT * DMOD || ws_size < WS_END) { fprintf(stderr, "kernel_launch: unexpected shapes (n_in %d, in0 %d, out %d, ws %zu)\n", n_in, n_in > 0 ? in_sizes[0] : -1, out_size, ws_size); grid = -1; return; }
        int dev = 0, cus = 0, per_cu = 0;
        if (hipGetDevice(&dev) != hipSuccess || hipDeviceGetAttribute(&cus, hipDeviceAttributeMultiprocessorCount, dev) != hipSuccess) { grid = -1; return; }
        if (hipFuncSetAttribute((const void*)fwd_kernel, hipFuncAttributeMaxDynamicSharedMemorySize, LDS_BYTES) != hipSuccess) { fprintf(stderr, "kernel_launch: hipFuncSetAttribute failed\n"); grid = -1; return; }
        if (hipOccupancyMaxActiveBlocksPerMultiprocessor(&per_cu, (const void*)fwd_kernel, NTHR, LDS_BYTES) != hipSuccess || per_cu < 1) { fprintf(stderr, "kernel_launch: occupancy query says %d blocks per CU\n", per_cu); (void)hipGetLastError(); grid = -1; return; }
        grid = cus;
    }
    if (grid < 0) return;
    if (hipMemsetAsync(d_ws, 0, 16384, stream) != hipSuccess) { fprintf(stderr, "kernel_launch: memset failed\n"); return; }
    Args a{};
    for (int i = 0; i < 28; ++i) a.in[i] = (const float*)d_in[i];
    a.out = (float*)d_out; a.ws = (unsigned char*)d_ws;
    void* args[] = {&a};
#if MK_N_LAUNCHES == 1
    a.ph_lo = 0; a.ph_hi = NPH;
    hipError_t e = hipLaunchCooperativeKernel((const void*)fwd_kernel, dim3(grid), dim3(NTHR), args, LDS_BYTES, stream);
    if (e != hipSuccess) fprintf(stderr, "kernel_launch: cooperative launch failed: %s (grid %d)\n", hipGetErrorString(e), grid);
#else
    for (int ph = 0; ph < NPH; ++ph) { a.ph_lo = ph; a.ph_hi = ph + 1;
        hipError_t e = hipLaunchCooperativeKernel((const void*)fwd_kernel, dim3(grid), dim3(NTHR), args, LDS_BYTES, stream);
        if (e != hipSuccess) { fprintf(stderr, "kernel_launch: cooperative launch %d failed: %s (grid %d)\n", ph, hipGetErrorString(e), grid); break; } }
#endif
}
```

```cpp
#include <hip/hip_runtime.h>
#include <hip/hip_cooperative_groups.h>
#include <hip/hip_bf16.h>
#include <cstdio>
#include <cstdint>
#include <cmath>
namespace cg = cooperative_groups;
namespace pg8 {
#define PG8_LAS __attribute__((address_space(3)))
typedef unsigned short bf16_t;
typedef short bf16x8 __attribute__((ext_vector_type(8)));
typedef float f32x4 __attribute__((ext_vector_type(4)));
typedef unsigned u32x4 __attribute__((ext_vector_type(4)));
constexpr int BM = 256, BK = 64, HALF = 128, HTB = HALF * BK * 2  , STAGE_BYTES = 8 * HTB, NXCD = 8, WGM = 8;

__host__ __device__ __forceinline__ int lds_byte(int r, int c) { const int st = (r >> 4) * 2 + (c >> 5), rr = r & 15, cc = c & 31, ob = rr * 64 + cc * 2; return st * 1024 + (ob ^ (((ob >> 9) & 1) << 5)); }
__host__ __device__ __forceinline__ void stage_rc(int b, int& R, int& C) { const int st = b / 1024, sb = b % 1024, swz = sb ^ (((sb >> 9) & 1) << 5); R = (st >> 1) * 16 + swz / 64; C = (st & 1) * 32 + (swz % 64) / 2; }
__host__ __device__ __forceinline__ int perm32(int rho) { const int n = rho >> 4, i = rho & 15; return 8 * (i >> 2) + 4 * n + (i & 3); }

struct Unit { int pm, pn; };
struct Gemm { const bf16_t* A; const bf16_t* Bt; int M, N, K; };

struct StaticOrder {
    int nM, nN, nwg, G, c;
    __host__ __device__ void init(int M, int N, int G_, int c_) { nM = M / BM; nN = N / BM; nwg = nM * nN; G = G_; c = c_; }
    __host__ __device__ bool next(int i, Unit& u) const {
        const long L = (long)i * G + c; if (L >= nwg) return false;
        int wgid = (int)L; { const int q = nwg / NXCD, r = nwg % NXCD, xcd = wgid % NXCD, off = wgid / NXCD; wgid = (xcd < r ? xcd * (q + 1) : r * (q + 1) + (xcd - r) * q) + off; }
        const int nig = WGM * nN, gid = wgid / nig, fm = gid * WGM, gsz = (nM - fm) < WGM ? (nM - fm) : WGM;
        u.pm = fm + ((wgid % nig) % gsz); u.pn = (wgid % nig) / gsz; return true;
    }
    __device__ __forceinline__ void a_ready(const Unit&) const {}
    __device__ __forceinline__ void done(const Unit&) const {}
};

__device__ __forceinline__ unsigned cvt_pk_bf16(float lo, float hi) { unsigned r; asm volatile("v_cvt_pk_bf16_f32 %0, %1, %2" : "=v"(r) : "v"(lo), "v"(hi)); return r; }
typedef float f32x2 __attribute__((ext_vector_type(2)));
__device__ __forceinline__ f32x2 gelu_pk(f32x2 v) {
    const f32x2 av = __builtin_elementwise_abs(v), d = av * 0.2316418882f + 1.0f;
    f32x2 t; t.x = __builtin_amdgcn_rcpf(d.x); t.y = __builtin_amdgcn_rcpf(d.y);
    f32x2 q = t * 0.5307027145f + (-0.7265760135f); q = q * t + 0.7107068705f; q = q * t + (-0.142248368f); q = q * t + 0.127414796f; q = q * t;
    const f32x2 s = (v * v) * (-0.72134752044f);
    f32x2 e; e.x = __builtin_amdgcn_exp2f(s.x); e.y = __builtin_amdgcn_exp2f(s.y);
    const f32x2 m = v * (q * e), r = v - m;
    f32x2 o; o.x = v.x < 0.f ? m.x : r.x; o.y = v.y < 0.f ? m.y : r.y; return o;
}

template <int ACT  > struct EpiBf16 {
    static constexpr bool PERM = true, AFTER_DRAIN = false; static_assert(ACT == 0 || ACT == 1, "EpiBf16: ACT is 0 (none) or 1 (gelu_pk)");
    bf16_t* O; int ldc; const float* bias; int split_cols; size_t split_stride; float scale0;
    __device__ __forceinline__ void operator()(const f32x4 (&acc)[2][2][4][2], const Unit& u, int wr, int wc, int fr, int fq) const {
        const int row0 = u.pm * BM + wr * 64 + fr; int colt = u.pn * BM; bf16_t* base = O;
        float sc = 1.f; if (split_cols) { const int t = colt / split_cols; base += (size_t)t * split_stride; colt -= t * split_cols; if (t == 0) sc = scale0; }
        const int col0 = colt + wc * 32 + 8 * fq, bcol0 = u.pn * BM + wc * 32 + 8 * fq;
        f32x4 bv[2][2];
#pragma unroll
        for (int bj = 0; bj < 2; ++bj)
#pragma unroll
            for (int n = 0; n < 2; ++n) bv[bj][n] = bias ? *(const f32x4*)(bias + bcol0 + bj * HALF + 4 * n) : (f32x4){0.f, 0.f, 0.f, 0.f};
#pragma unroll
        for (int ai = 0; ai < 2; ++ai)
#pragma unroll
            for (int m = 0; m < 4; ++m) { bf16_t* rowp = base + (size_t)(row0 + ai * HALF + m * 16) * ldc + col0;
#pragma unroll
                for (int bj = 0; bj < 2; ++bj) { f32x4 v0 = acc[ai][bj][m][0] + bv[bj][0], v1 = acc[ai][bj][m][1] + bv[bj][1];
                    if (ACT == 1) { f32x2 a = gelu_pk((f32x2){v0[0], v0[1]}), b = gelu_pk((f32x2){v0[2], v0[3]}), c = gelu_pk((f32x2){v1[0], v1[1]}), d = gelu_pk((f32x2){v1[2], v1[3]});
                        v0 = (f32x4){a.x, a.y, b.x, b.y}; v1 = (f32x4){c.x, c.y, d.x, d.y}; }
                    v0 = v0 * sc; v1 = v1 * sc; u32x4 w; w.x = cvt_pk_bf16(v0[0], v0[1]); w.y = cvt_pk_bf16(v0[2], v0[3]); w.z = cvt_pk_bf16(v1[0], v1[1]); w.w = cvt_pk_bf16(v1[2], v1[3]);
                    *(u32x4*)(rowp + bj * HALF) = w; } }
    }
};
__device__ __forceinline__ float bflo(unsigned u) { return __uint_as_float(u << 16); }
__device__ __forceinline__ float bfhi(unsigned u) { return __uint_as_float(u & 0xffff0000u); }
__device__ __forceinline__ float sigm(float x) { return __builtin_amdgcn_rcpf(1.0f + __expf(-x)); }
struct EpiBf16Row {
    static constexpr bool PERM = true, AFTER_DRAIN = false;
    bf16_t* O; int ldc; const float* rs;
    __device__ __forceinline__ void operator()(const f32x4 (&acc)[2][2][4][2], const Unit& u, int wr, int wc, int fr, int fq) const {
        const int row0 = u.pm * BM + wr * 64 + fr, col0 = u.pn * BM + wc * 32 + 8 * fq;
        const bool silu_tile = (u.pn >= 8 && u.pn < 12) || u.pn >= 24;
        if (u.pn < 8) {
#pragma unroll
            for (int ai = 0; ai < 2; ++ai)
#pragma unroll
                for (int m = 0; m < 4; ++m) { const int row = row0 + ai * HALF + m * 16; const float sc = rs[row];
                    const f32x4 v0 = acc[ai][0][m][0] * sc, v1 = acc[ai][0][m][1] * sc, g0 = acc[ai][1][m][0] * sc, g1 = acc[ai][1][m][1] * sc;
                    u32x4 w; w.x = cvt_pk_bf16(v0[0] * sigm(g0[0]), v0[1] * sigm(g0[1])); w.y = cvt_pk_bf16(v0[2] * sigm(g0[2]), v0[3] * sigm(g0[3]));
                    w.z = cvt_pk_bf16(v1[0] * sigm(g1[0]), v1[1] * sigm(g1[1])); w.w = cvt_pk_bf16(v1[2] * sigm(g1[2]), v1[3] * sigm(g1[3]));
                    *(u32x4*)(O + (size_t)row * ldc + u.pn * 128 + wc * 32 + 8 * fq) = w; }
            return; }
#pragma unroll
        for (int ai = 0; ai < 2; ++ai)
#pragma unroll
            for (int m = 0; m < 4; ++m) { const int row = row0 + ai * HALF + m * 16; const float sc = rs[row]; bf16_t* rowp = O + (size_t)row * ldc + col0;
#pragma unroll
                for (int bj = 0; bj < 2; ++bj) { f32x4 v0 = acc[ai][bj][m][0] * sc, v1 = acc[ai][bj][m][1] * sc;
                    if (silu_tile) {
#pragma unroll
                        for (int e = 0; e < 4; ++e) { v0[e] *= sigm(v0[e]); v1[e] *= sigm(v1[e]); } }
                    u32x4 w; w.x = cvt_pk_bf16(v0[0], v0[1]); w.y = cvt_pk_bf16(v0[2], v0[3]); w.z = cvt_pk_bf16(v1[0], v1[1]); w.w = cvt_pk_bf16(v1[2], v1[3]);
                    *(u32x4*)(rowp + bj * HALF) = w; } }
    }
};
struct EpiResF32 {
    static constexpr bool PERM = false, AFTER_DRAIN = false;
    const float* base; float* out; int ldc;
    __device__ __forceinline__ void operator()(const f32x4 (&acc)[2][2][4][2], const Unit& u, int wr, int wc, int fr, int fq) const {
        const int row0 = u.pm * BM + wr * 64 + fr, col0 = u.pn * BM + wc * 32 + 4 * fq;
#pragma unroll
        for (int ai = 0; ai < 2; ++ai)
#pragma unroll
            for (int m = 0; m < 4; ++m) { const size_t off = (size_t)(row0 + ai * HALF + m * 16) * ldc + col0;
#pragma unroll
                for (int bj = 0; bj < 2; ++bj)
#pragma unroll
                    for (int n = 0; n < 2; ++n) { const f32x4 b = *(const f32x4*)(base + off + bj * HALF + n * 16); *(f32x4*)(out + off + bj * HALF + n * 16) = b + acc[ai][bj][m][n]; } }
    }
};
struct EpiResNorm {
    static constexpr bool PERM = true, AFTER_DRAIN = false;
    bf16_t* X; float* sumsq;
    __device__ __forceinline__ void operator()(const f32x4 (&acc)[2][2][4][2], const Unit& u, int wr, int wc, int fr, int fq) const {
        const int row0 = u.pm * BM + wr * 64 + fr, colb = u.pn * BM + wc * 32 + 8 * fq;
#pragma unroll
        for (int ai = 0; ai < 2; ++ai) {
            u32x4 xb[4][2];
#pragma unroll
            for (int m = 0; m < 4; ++m)
#pragma unroll
                for (int bj = 0; bj < 2; ++bj) xb[m][bj] = *(const u32x4*)(X + (size_t)(row0 + ai * HALF + m * 16) * 2048 + colb + bj * HALF);
#pragma unroll
            for (int m = 0; m < 4; ++m) { const int row = row0 + ai * HALF + m * 16; const size_t off = (size_t)row * 2048 + colb; float ss = 0.f;
#pragma unroll
                for (int bj = 0; bj < 2; ++bj) { const u32x4 xv = xb[m][bj];
                    const f32x4 x0 = (f32x4){bflo(xv.x), bfhi(xv.x), bflo(xv.y), bfhi(xv.y)} + acc[ai][bj][m][0], x1 = (f32x4){bflo(xv.z), bfhi(xv.z), bflo(xv.w), bfhi(xv.w)} + acc[ai][bj][m][1];
                    ss += (x0[0] * x0[0] + x0[1] * x0[1]) + (x0[2] * x0[2] + x0[3] * x0[3]) + (x1[0] * x1[0] + x1[1] * x1[1]) + (x1[2] * x1[2] + x1[3] * x1[3]);
                    u32x4 w; w.x = cvt_pk_bf16(x0[0], x0[1]); w.y = cvt_pk_bf16(x0[2], x0[3]); w.z = cvt_pk_bf16(x1[0], x1[1]); w.w = cvt_pk_bf16(x1[2], x1[3]);
                    *(u32x4*)(X + off + bj * HALF) = w; }
                ss += __shfl_xor(ss, 16); ss += __shfl_xor(ss, 32);
                if (fq == 0) (void)__hip_atomic_fetch_add(sumsq + row, ss, __ATOMIC_RELAXED, __HIP_MEMORY_SCOPE_AGENT); } }
    }
};
struct EpiResOut {
    static constexpr bool PERM = true, AFTER_DRAIN = false;
    const bf16_t* base; float* out;
    __device__ __forceinline__ void operator()(const f32x4 (&acc)[2][2][4][2], const Unit& u, int wr, int wc, int fr, int fq) const {
        const int row0 = u.pm * BM + wr * 64 + fr, colb = u.pn * BM + wc * 32 + 8 * fq;
#pragma unroll
        for (int ai = 0; ai < 2; ++ai) {
            u32x4 xb[4][2];
#pragma unroll
            for (int m = 0; m < 4; ++m)
#pragma unroll
                for (int bj = 0; bj < 2; ++bj) xb[m][bj] = *(const u32x4*)(base + (size_t)(row0 + ai * HALF + m * 16) * 2048 + colb + bj * HALF);
#pragma unroll
            for (int m = 0; m < 4; ++m) { const size_t off = (size_t)(row0 + ai * HALF + m * 16) * 2048 + colb;
#pragma unroll
                for (int bj = 0; bj < 2; ++bj) { const u32x4 xv = xb[m][bj];
                    *(f32x4*)(out + off + bj * HALF) = (f32x4){bflo(xv.x), bfhi(xv.x), bflo(xv.y), bfhi(xv.y)} + acc[ai][bj][m][0];
                    *(f32x4*)(out + off + bj * HALF + 4) = (f32x4){bflo(xv.z), bfhi(xv.z), bflo(xv.w), bfhi(xv.w)} + acc[ai][bj][m][1]; } } }
    }
};
struct EpiUG {
    static constexpr bool PERM = true, AFTER_DRAIN = false;
    bf16_t* Ugm; bf16_t* Gate; int mrows; const float* sumsq;
    __device__ __forceinline__ void operator()(const f32x4 (&acc)[2][2][4][2], const Unit& u, int wr, int wc, int fr, int fq) const {
        const int row0 = u.pm * BM + wr * 64 + fr, colb = u.pn * BM + wc * 32 + 8 * fq;
#pragma unroll
        for (int ai = 0; ai < 2; ++ai)
#pragma unroll
            for (int m = 0; m < 4; ++m) { const int row = row0 + ai * HALF + m * 16; const float rs = 1.0f / sqrtf(sumsq[row] * (1.0f / 2048.0f) + 1e-6f);
#pragma unroll
                for (int bj = 0; bj < 2; ++bj) { const int col = colb + bj * HALF; const f32x4 v0 = acc[ai][bj][m][0] * rs, v1 = acc[ai][bj][m][1] * rs;
                    u32x4 w; w.x = cvt_pk_bf16(v0[0], v0[1]); w.y = cvt_pk_bf16(v0[2], v0[3]); w.z = cvt_pk_bf16(v1[0], v1[1]); w.w = cvt_pk_bf16(v1[2], v1[3]);
                    if (col < 2048) *(u32x4*)(Ugm + ((size_t)(col >> 4) * mrows + row) * 16 + (col & 8)) = w;
                    else *(u32x4*)(Gate + (size_t)row * 2048 + (col - 2048)) = w; } }
    }
};
struct EpiGlu {
    static constexpr bool PERM = true, AFTER_DRAIN = false;
    const bf16_t* Z; const bf16_t* Gate; bf16_t* O; const float* bias;
    __device__ __forceinline__ void operator()(const f32x4 (&acc)[2][2][4][2], const Unit& u, int wr, int wc, int fr, int fq) const {
        const int row0 = u.pm * BM + wr * 64 + fr, colb = u.pn * BM + wc * 32 + 8 * fq;
        f32x4 bv[2][2];
#pragma unroll
        for (int bj = 0; bj < 2; ++bj)
#pragma unroll
            for (int n = 0; n < 2; ++n) bv[bj][n] = *(const f32x4*)(bias + colb + bj * HALF + 4 * n);
#pragma unroll
        for (int ai = 0; ai < 2; ++ai)
#pragma unroll
            for (int m = 0; m < 4; ++m) { const size_t roff = (size_t)(row0 + ai * HALF + m * 16) * 2048 + colb;
#pragma unroll
                for (int bj = 0; bj < 2; ++bj) { const f32x4 v0 = acc[ai][bj][m][0] + bv[bj][0], v1 = acc[ai][bj][m][1] + bv[bj][1];
                    const u32x4 zz = *(const u32x4*)(Z + roff + bj * HALF), gg = *(const u32x4*)(Gate + roff + bj * HALF);
                    float o[8]; const float a[8] = {v0[0], v0[1], v0[2], v0[3], v1[0], v1[1], v1[2], v1[3]};
#pragma unroll
                    for (int q = 0; q < 4; ++q) { const unsigned zw = zz[q], gw = gg[q]; const float z0 = bflo(zw), z1 = bfhi(zw), g0 = bflo(gw), g1 = bfhi(gw);
                        o[2 * q] = z0 * sigm(a[2 * q]) * (g0 * sigm(g0)); o[2 * q + 1] = z1 * sigm(a[2 * q + 1]) * (g1 * sigm(g1)); }
                    u32x4 w; w.x = cvt_pk_bf16(o[0], o[1]); w.y = cvt_pk_bf16(o[2], o[3]); w.z = cvt_pk_bf16(o[4], o[5]); w.w = cvt_pk_bf16(o[6], o[7]);
                    *(u32x4*)(O + roff + bj * HALF) = w; } }
    }
};

template <class Epi, class Sched, bool ALIGN_EPI = false, bool SP2 = false>
__device__ __forceinline__ void gemm_phase(PG8_LAS unsigned char* lds, const Gemm g, const Sched& S, const Epi& E) {
    const int tid = threadIdx.x, wid = __builtin_amdgcn_readfirstlane(tid >> 6), lane = tid & 63, wr = wid >> 2, wc = wid & 3, fr = lane & 15, fq = lane >> 4;
    const int K = g.K, nt = K / BK;
    unsigned voffA[2], voffB[2];
#pragma unroll
    for (int i = 0; i < 2; ++i) { int R, C; stage_rc(tid * 16 + i * 8192, R, C); const int Rb = Epi::PERM ? ((R & ~31) + perm32(R & 31)) : R;
        voffA[i] = (unsigned)(R * K + C) * 2u; voffB[i] = (unsigned)(Rb * K + C) * 2u; }
    const size_t kstep = (size_t)(BK * 2);
    const size_t hstep = (size_t)HALF * K * 2;
    const size_t tstep = 2 * hstep;
    const unsigned ldsw = (unsigned)wid * 1024u;
    const int aoff = lds_byte(wr * 64 + fr, fq * 8), boff = lds_byte(wc * 32 + fr, fq * 8);
#define PG8_SA(b, h) (((b) * 2 + (h)) * HTB)
#define PG8_SB(b, h) ((4 + (b) * 2 + (h)) * HTB)
#define PG8_STAGE(bufoff, gbase, voff) do { _Pragma("unroll") for (int _i = 0; _i < 2; ++_i) \
        __builtin_amdgcn_global_load_lds((const unsigned*)((const char*)(gbase) + (voff)[_i]), (PG8_LAS unsigned*)(lds + (bufoff) + ldsw + _i * 8192), 16, 0, 0); } while (0)
#define PG8_LDA(dst, b, h) do { _Pragma("unroll") for (int m = 0; m < 4; ++m) _Pragma("unroll") for (int k = 0; k < 2; ++k) dst[m][k] = *(const PG8_LAS bf16x8*)(lds + PG8_SA(b, h) + aoff + m * 2048 + k * 1024); } while (0)
#define PG8_LDB(dst, b, h) do { _Pragma("unroll") for (int n = 0; n < 2; ++n) _Pragma("unroll") for (int k = 0; k < 2; ++k) dst[n][k] = *(const PG8_LAS bf16x8*)(lds + PG8_SB(b, h) + boff + n * 2048 + k * 1024); } while (0)
#define PG8_MMA(ai, bj, At, Bt) do { __builtin_amdgcn_s_setprio(1); _Pragma("unroll") for (int m = 0; m < 4; ++m) _Pragma("unroll") for (int n = 0; n < 2; ++n) _Pragma("unroll") for (int k = 0; k < 2; ++k) \
        acc[ai][bj][m][n] = __builtin_amdgcn_mfma_f32_16x16x32_bf16(Bt[n][k], At[m][k], acc[ai][bj][m][n], 0, 0, 0); __builtin_amdgcn_s_setprio(0); } while (0)
#define PG8_WAIT_V(n) asm volatile("s_waitcnt vmcnt(" #n ")" ::: "memory")
#define PG8_WAIT_L(n) asm volatile("s_waitcnt lgkmcnt(" #n ")" ::: "memory")
#define PG8_BAR __builtin_amdgcn_s_barrier()
#define PG8_SCHED __builtin_amdgcn_sched_barrier(0)
    Unit cur, nxt; int ui = 0;
    if (!S.next(0, cur)) return;
    f32x4 acc[2][2][4][2];
#pragma unroll
    for (int a = 0; a < 2; ++a)
#pragma unroll
        for (int b = 0; b < 2; ++b)
#pragma unroll
            for (int m = 0; m < 4; ++m)
#pragma unroll
                for (int n = 0; n < 2; ++n) acc[a][b][m][n] = (f32x4){0.f, 0.f, 0.f, 0.f};
    bf16x8 At[4][2], B0[2][2], B1[2][2];
    const char* cA = (const char*)g.A + (size_t)cur.pm * tstep; const char* cB = (const char*)g.Bt + (size_t)cur.pn * tstep;
    S.a_ready(cur);
    if constexpr (SP2) {
        PG8_STAGE(PG8_SB(0, 0), cB, voffB); PG8_STAGE(PG8_SB(0, 1), cB + hstep, voffB); PG8_STAGE(PG8_SA(0, 0), cA, voffA); PG8_STAGE(PG8_SA(0, 1), cA + hstep, voffA);
        if (wr == 1) PG8_BAR;
        PG8_WAIT_V(2); PG8_BAR;
        PG8_STAGE(PG8_SB(1, 0), cB + kstep, voffB); PG8_STAGE(PG8_SA(1, 0), cA + kstep, voffA); PG8_STAGE(PG8_SB(1, 1), cB + hstep + kstep, voffB);
        PG8_WAIT_V(6); PG8_BAR;
    } else {
        PG8_STAGE(PG8_SB(0, 0), cB, voffB); PG8_STAGE(PG8_SA(0, 0), cA, voffA); PG8_STAGE(PG8_SB(0, 1), cB + hstep, voffB); PG8_STAGE(PG8_SA(0, 1), cA + hstep, voffA);
        if (wr == 1) PG8_BAR;
        PG8_WAIT_V(4); PG8_BAR;
        PG8_STAGE(PG8_SB(1, 0), cB + kstep, voffB); PG8_STAGE(PG8_SA(1, 0), cA + kstep, voffA); PG8_STAGE(PG8_SB(1, 1), cB + hstep + kstep, voffB);
        PG8_WAIT_V(6); PG8_BAR;
    }
    for (;;) {
        const bool has_next = S.next(ui + 1, nxt);
        const char* nA = has_next ? (const char*)g.A + (size_t)nxt.pm * tstep : cA; const char* nB = has_next ? (const char*)g.Bt + (size_t)nxt.pn * tstep : cB;
        for (int t = 0; t < nt; t += 2) {
            const bool last = (t == nt - 2);
            const char* a1 = cA + (size_t)(t + 1) * kstep;
            const char* a2 = last ? nA : cA + (size_t)(t + 2) * kstep; const char* b2 = last ? nB : cB + (size_t)(t + 2) * kstep;
            const char* a3 = a2 + kstep; const char* b3 = b2 + kstep;
            if (last && has_next) S.a_ready(nxt);
            if constexpr (SP2) {
            PG8_LDB(B0, 0, 0); PG8_LDB(B1, 0, 1); PG8_SCHED; PG8_LDA(At, 0, 0); PG8_STAGE(PG8_SA(1, 1), a1 + hstep, voffA);
            PG8_WAIT_V(8); PG8_WAIT_L(0); PG8_BAR; PG8_MMA(0, 0, At, B0); PG8_MMA(0, 1, At, B1); PG8_BAR; PG8_SCHED;
            PG8_LDA(At, 0, 1); PG8_STAGE(PG8_SB(0, 0), b2, voffB); PG8_STAGE(PG8_SB(0, 1), b2 + hstep, voffB); PG8_STAGE(PG8_SA(0, 0), a2, voffA);
            PG8_WAIT_V(8); PG8_WAIT_L(0); PG8_BAR; PG8_MMA(1, 0, At, B0); PG8_MMA(1, 1, At, B1); PG8_BAR; PG8_SCHED;
            PG8_LDB(B0, 1, 0); PG8_LDB(B1, 1, 1); PG8_SCHED; PG8_LDA(At, 1, 0); PG8_STAGE(PG8_SA(0, 1), a2 + hstep, voffA);
            PG8_WAIT_V(8); PG8_WAIT_L(0); PG8_BAR; PG8_MMA(0, 0, At, B0); PG8_MMA(0, 1, At, B1); PG8_BAR; PG8_SCHED;
            PG8_LDA(At, 1, 1); PG8_STAGE(PG8_SB(1, 0), b3, voffB); PG8_STAGE(PG8_SB(1, 1), b3 + hstep, voffB); PG8_STAGE(PG8_SA(1, 0), a3, voffA);
            PG8_WAIT_V(8); PG8_WAIT_L(0); PG8_BAR; PG8_MMA(1, 0, At, B0); PG8_MMA(1, 1, At, B1); PG8_BAR; PG8_SCHED;
            } else {
            PG8_LDB(B0, 0, 0); PG8_SCHED; PG8_LDA(At, 0, 0); PG8_STAGE(PG8_SA(1, 1), a1 + hstep, voffA);
            PG8_WAIT_L(8); PG8_BAR; PG8_WAIT_L(0); PG8_MMA(0, 0, At, B0); PG8_BAR; PG8_SCHED;
            PG8_LDB(B1, 0, 1); PG8_STAGE(PG8_SB(0, 0), b2, voffB);
            PG8_BAR; PG8_WAIT_L(0); PG8_MMA(0, 1, At, B1); PG8_BAR;
            PG8_LDA(At, 0, 1); PG8_STAGE(PG8_SA(0, 0), a2, voffA);
            PG8_BAR; PG8_WAIT_L(0); PG8_MMA(1, 0, At, B0); PG8_BAR; PG8_SCHED;
            PG8_STAGE(PG8_SB(0, 1), b2 + hstep, voffB);
            PG8_WAIT_V(6); PG8_BAR; PG8_MMA(1, 1, At, B1); PG8_BAR;
            PG8_LDB(B0, 1, 0); PG8_SCHED; PG8_LDA(At, 1, 0); PG8_STAGE(PG8_SA(0, 1), a2 + hstep, voffA);
            PG8_WAIT_L(8); PG8_BAR; PG8_WAIT_L(0); PG8_MMA(0, 0, At, B0); PG8_BAR; PG8_SCHED;
            PG8_LDB(B1, 1, 1); PG8_STAGE(PG8_SB(1, 0), b3, voffB);
            PG8_BAR; PG8_WAIT_L(0); PG8_MMA(0, 1, At, B1); PG8_BAR;
            PG8_LDA(At, 1, 1); PG8_STAGE(PG8_SA(1, 0), a3, voffA);
            PG8_BAR; PG8_WAIT_L(0); PG8_MMA(1, 0, At, B0); PG8_BAR; PG8_SCHED;
            PG8_STAGE(PG8_SB(1, 1), b3 + hstep, voffB);
            PG8_WAIT_V(6); PG8_BAR; PG8_MMA(1, 1, At, B1); PG8_BAR;
            }
        }
        if constexpr (ALIGN_EPI) { if (wr == 0) PG8_BAR; }
        if constexpr (!Epi::AFTER_DRAIN) { E(acc, cur, wr, wc, fr, fq); S.done(cur); }
        if (!has_next) break;
#pragma unroll
        for (int a = 0; a < 2; ++a)
#pragma unroll
            for (int b = 0; b < 2; ++b)
#pragma unroll
                for (int m = 0; m < 4; ++m)
#pragma unroll
                    for (int n = 0; n < 2; ++n) acc[a][b][m][n] = (f32x4){0.f, 0.f, 0.f, 0.f};
        cur = nxt; cA = nA; cB = nB; ++ui;
        if constexpr (ALIGN_EPI) { if (wr == 1) PG8_BAR; }
    }
    PG8_WAIT_V(0);
    if constexpr (!ALIGN_EPI) { if (wr == 0) PG8_BAR; }
    PG8_BAR;
    if constexpr (Epi::AFTER_DRAIN) { E.fused(acc, cur, wr, wc, fr, fq, lds, wid, lane); S.done(cur); }
#undef PG8_SA
#undef PG8_SB
#undef PG8_STAGE
#undef PG8_LDA
#undef PG8_LDB
#undef PG8_MMA
#undef PG8_WAIT_V
#undef PG8_WAIT_L
#undef PG8_BAR
#undef PG8_SCHED
}
}

#ifndef PG8_SP2
#define PG8_SP2 true
#endif
#ifndef PG8_ALIGN
#define PG8_ALIGN true
#endif
namespace attn_body {
using bf16=__hip_bfloat16;
using bf16x8=__attribute__((ext_vector_type(8)))short;
using s16x4=__attribute__((ext_vector_type(4)))short;
using f32x16=__attribute__((ext_vector_type(16)))float;
using u32x4=__attribute__((ext_vector_type(4)))unsigned;
constexpr int SEQ=4096,D=64,DM=7168,OPITCH=7168;
constexpr int NW=8,QBLK=32,QB=QBLK*NW,KVBLK=64,NQB=SEQ/QB;
constexpr int ATTN_PITCH=DM, ATTN_UNIT_ROWS=QB;
__device__ __forceinline__ int crow(int r,int hi){return (r&3)+8*(r>>2)+4*hi;}
#define SBAR() __builtin_amdgcn_sched_barrier(0)
__device__ __forceinline__ void cmask(f32x16&p0,f32x16&p1,int jb,int qrel,int hi){
  const float NEG=-INFINITY; int kb=64*jb+4*hi;
  #pragma unroll
  for(int r=0;r<16;++r){int kv=kb+(r&3)+8*(r>>2); if(kv>qrel)p0[r]=NEG; if(kv+32>qrel)p1[r]=NEG;}
}

constexpr int NSLOT=3, SLOTB=8192;
constexpr int VSLOTB=2*SLOTB;
constexpr int LDS_K=0, LDS_V=NSLOT*SLOTB, LDS_WS=LDS_V+NSLOT*VSLOTB, LDS_OST=LDS_WS+NW*64*4, LDS_BYTES=LDS_OST+NW*8192;
constexpr float C2=0.125f*1.4426950408889634f;
__device__ __forceinline__ void glds16(const void*gsrc,unsigned lds_dst){unsigned keep;
  asm volatile("s_mov_b32 %0, m0\n\ts_mov_b32 m0, %2\n\ts_nop 0\n\tglobal_load_lds_dwordx4 %1, off\n\ts_mov_b32 m0, %0":"=&s"(keep):"v"(gsrc),"s"(lds_dst):"memory");}
__device__ __forceinline__ float max3f(float a,float b,float c){float r;asm("v_max3_f32 %0, %1, %2, %3":"=v"(r):"v"(a),"v"(b),"v"(c));return r;}
__device__ __forceinline__ float max2f(float a,float b){float r;asm("v_max_f32_e32 %0, %1, %2":"=v"(r):"v"(a),"v"(b));return r;}
__device__ __forceinline__ float fadd_s(float a,float b){float r;asm("v_add_f32_e32 %0, %1, %2":"=v"(r):"v"(a),"v"(b));return r;}
__device__ __forceinline__ float fsub_s(float a,float b){float r;asm("v_sub_f32_e32 %0, %1, %2":"=v"(r):"v"(a),"v"(b));return r;}
typedef float f32x2_t __attribute__((ext_vector_type(2))); typedef __bf16 bf16x2_t __attribute__((ext_vector_type(2)));
__device__ __forceinline__ unsigned cvtpk_s(float lo,float hi){f32x2_t v={lo,hi};bf16x2_t b=__builtin_convertvector(v,bf16x2_t);return __builtin_bit_cast(unsigned,b);}
#define WAIT_BAR(N) asm volatile("s_waitcnt vmcnt(" #N ") lgkmcnt(0)\n\ts_barrier":::"memory")

__device__ __forceinline__ void qkt(f32x16&p0,f32x16&p1,const char*Kslot,const bf16x8*qr,int r32,int hi){
  const char*kb=Kslot+hi*1024+r32*16;
  #pragma unroll
  for(int d0=0;d0<4;++d0){
    const bf16x8 b0=*reinterpret_cast<const bf16x8*>(kb+d0*2048);
    const bf16x8 b1=*reinterpret_cast<const bf16x8*>(kb+d0*2048+512);
    if(d0==0){p0=__builtin_amdgcn_mfma_f32_32x32x16_bf16(b0,qr[0],f32x16{},0,0,0);p1=__builtin_amdgcn_mfma_f32_32x32x16_bf16(b1,qr[0],f32x16{},0,0,0);}
    else{p0=__builtin_amdgcn_mfma_f32_32x32x16_bf16(b0,qr[d0],p0,0,0,0);p1=__builtin_amdgcn_mfma_f32_32x32x16_bf16(b1,qr[d0],p1,0,0,0);}}
}
typedef __attribute__((address_space(3))) const char* lds_cptr;
typedef short v4i16_t __attribute__((ext_vector_type(4)));
__device__ __forceinline__ void kload8(bf16x8*kf,lds_cptr kp){
  kf[0]=*(const __attribute__((address_space(3))) bf16x8*)(kp);      kf[1]=*(const __attribute__((address_space(3))) bf16x8*)(kp+512);
  kf[2]=*(const __attribute__((address_space(3))) bf16x8*)(kp+2048); kf[3]=*(const __attribute__((address_space(3))) bf16x8*)(kp+2560);
  kf[4]=*(const __attribute__((address_space(3))) bf16x8*)(kp+4096); kf[5]=*(const __attribute__((address_space(3))) bf16x8*)(kp+4608);
  kf[6]=*(const __attribute__((address_space(3))) bf16x8*)(kp+6144); kf[7]=*(const __attribute__((address_space(3))) bf16x8*)(kp+6656);
}
__device__ __forceinline__ void kload2(bf16x8*kf,lds_cptr kp,int j){ kf[2*j]=*(const __attribute__((address_space(3))) bf16x8*)(kp+j*2048); kf[2*j+1]=*(const __attribute__((address_space(3))) bf16x8*)(kp+j*2048+512); }
__device__ __forceinline__ s16x4 vtr(lds_cptr p){ return __builtin_bit_cast(s16x4,__builtin_amdgcn_ds_read_tr16_b64_v4i16((__attribute__((address_space(3))) v4i16_t*)p)); }
__device__ __forceinline__ float rowmax(const f32x16&p0,const f32x16&p1){
  float a=max3f(p0[0],p0[1],p1[0]),b=max3f(p0[2],p0[3],p1[1]);a=max3f(a,p1[2],p1[3]);
  #pragma unroll
  for(int r=4;r<16;r+=4){a=max3f(a,p0[r],p0[r+1]);b=max3f(b,p0[r+2],p0[r+3]);a=max3f(a,p1[r],p1[r+1]);b=max3f(b,p1[r+2],p1[r+3]);}
  const float m=max2f(a,b);
  auto rr=__builtin_amdgcn_permlane32_swap(__float_as_uint(m),__float_as_uint(m),false,false);
  return max2f(__uint_as_float(rr[0]),__uint_as_float(rr[1]));
}
__device__ __forceinline__ void pv(f32x16*o,int vb,bf16x8 pa0,bf16x8 pa1,bf16x8 pa2,bf16x8 pa3){
  #pragma unroll
  for(int d0=0;d0<4;++d0){s16x4 lo[4],hi[4];
    #pragma unroll
    for(int ks=0;ks<4;++ks){
      asm volatile("ds_read_b64_tr_b16 %0,%1 offset:%c2":"=&v"(lo[ks]):"v"(vb),"i"(d0*4096+ks*1024):"memory");
      asm volatile("ds_read_b64_tr_b16 %0,%1 offset:%c2":"=&v"(hi[ks]):"v"(vb),"i"(d0*4096+ks*1024+512):"memory");}
    asm volatile("s_waitcnt lgkmcnt(0)":::"memory");SBAR();
    #define PK(k) (bf16x8){lo[k][0],lo[k][1],lo[k][2],lo[k][3],hi[k][0],hi[k][1],hi[k][2],hi[k][3]}
    o[d0]=__builtin_amdgcn_mfma_f32_32x32x16_bf16(pa0,PK(0),o[d0],0,0,0);
    o[d0]=__builtin_amdgcn_mfma_f32_32x32x16_bf16(pa1,PK(1),o[d0],0,0,0);
    o[d0]=__builtin_amdgcn_mfma_f32_32x32x16_bf16(pa2,PK(2),o[d0],0,0,0);
    o[d0]=__builtin_amdgcn_mfma_f32_32x32x16_bf16(pa3,PK(3),o[d0],0,0,0);
    #undef PK
  }
}

#ifndef ATTN_STORE16
#define ATTN_STORE16(p,v) (*(u32x4*)(p)=(v))
#endif
template<int THRL> __device__ __forceinline__ void attn_unit(int b,int qb,const bf16*Q,const bf16*K,const bf16*V,bf16*O,char*shm){
  const int tid=threadIdx.x,lane=tid&63,r32=lane&31,hi=lane>>5; const int wid=__builtin_amdgcn_readfirstlane(tid>>6);
  const long rowbase=(long)b*SEQ; const int q0=qb*QB;
  const bf16*Qw=Q+(rowbase+q0+wid*QBLK)*DM;
  const bf16*Kh=K+rowbase*DM,*Vh=V+rowbase*DM;
  const unsigned lds0=(unsigned)(uintptr_t)shm;
  float*wsf=(float*)(shm+LDS_WS)+wid*64;
  const bf16*ksrc=Kh+(long)lane*DM+wid*8;
  const bf16*vsrc=Vh+(long)(16*(wid&3)+(lane>>2))*DM+(wid>>2)*32+(lane&3)*8;
  const unsigned kdst=lds0+LDS_K+wid*1024, vdst=lds0+LDS_V+wid*1024;
  #define DMA_K(t,slot) glds16(ksrc+(long)(t)*KVBLK*DM,(unsigned)__builtin_amdgcn_readfirstlane(kdst+(slot)))
  #define DMA_V(t,slot) do{ glds16(vsrc+(long)(t)*KVBLK*DM,(unsigned)__builtin_amdgcn_readfirstlane(vdst+2*(slot))); glds16(vsrc+64+(long)(t)*KVBLK*DM,(unsigned)__builtin_amdgcn_readfirstlane(vdst+8192+2*(slot))); }while(0)
  const int vb0=(int)(lds0+LDS_V)+((lane>>4)&1)*32+(lane&3)*8+(4*hi+((lane&15)>>2))*64;
  const char*Kbase=shm+LDS_K; bf16x8 kf[8];
  const lds_cptr shm3=(lds_cptr)shm; const lds_cptr kp0=shm3+LDS_K+hi*1024+r32*16; const lds_cptr vp0=shm3+LDS_V+((lane>>4)&1)*32+(lane&3)*8+(4*hi+((lane&15)>>2))*64;
  const int NT=(q0+QB)/KVBLK;
  DMA_K(0,0);DMA_V(0,0);DMA_K(1,SLOTB);
  bf16x8 qr[4];
  #pragma unroll
  for(int d0=0;d0<4;++d0)qr[d0]=*reinterpret_cast<const bf16x8*>(&Qw[(long)r32*DM+d0*16+hi*8]);
  float mhat=0.f,l_reg=0.f;f32x16 o[4];o[0]=f32x16{};o[1]=f32x16{};o[2]=f32x16{};o[3]=f32x16{};
  const int qrel=wid*QBLK+r32;
  #define CMASK(P0,P1,t) do{int jb_=(t)-(NT-4); if(jb_>=0)cmask(P0,P1,jb_,qrel,hi);}while(0)
  bool resc=false;
  #define START(P0,P1) do{ const float rm=rowmax(P0,P1); resc=false; \
    { const float dl=rm; mhat=fadd_s(mhat,dl); \
      _Pragma("unroll") for(int r=0;r<16;++r){P0[r]=fsub_s(P0[r],dl);P1[r]=fsub_s(P1[r],dl);} \
      } \
    _Pragma("unroll") for(int r=0;r<16;++r)P0[r]=__builtin_amdgcn_exp2f(P0[r]); }while(0)
  #define RESC() do{ if(resc){ asm volatile("s_waitcnt lgkmcnt(0)":::"memory"); \
      _Pragma("unroll") for(int d_=0;d_<4;++d_) _Pragma("unroll") for(int r=0;r<16;++r)o[d_][r]*=wsf[crow(r,hi)]; } }while(0)
  f32x16 pA0,pA1,pB0,pB1;
  int sl_prev=0,sl_cur=0,sl_next=SLOTB;
  #define ROT() do{sl_prev=sl_cur;sl_cur=sl_next;sl_next=(sl_next==(NSLOT-1)*SLOTB)?0:sl_next+SLOTB;}while(0)
  DMA_K(2,2*SLOTB);
  WAIT_BAR(3);
  qkt(pA0,pA1,Kbase,qr,r32,hi);asm volatile("s_nop 15\n\ts_nop 7":"+v"(pA0),"+v"(pA1));CMASK(pA0,pA1,0);
  START(pA0,pA1);
  _Pragma("unroll") for(int r=0;r<16;++r)pA1[r]=__builtin_amdgcn_exp2f(pA1[r]);
  WAIT_BAR(0);
  DMA_K(3,0);DMA_V(1,SLOTB);
  ROT();
  kload8(kf,kp0+sl_cur);
  WAIT_BAR(3);
  s16x4 vlo[4],vhi[4]; u32x4 pw0,pw1,pw2,pw3;
  #define PKW(P,B) cvtpk_s(P[B],P[B+1])
  #define PAF(k) __builtin_bit_cast(bf16x8,pw##k)
  #define VFRW(s) (bf16x8){vlo[s][0],vlo[s][1],vlo[s][2],vlo[s][3],vhi[s][0],vhi[s][1],vhi[s][2],vhi[s][3]}
  #define PIN(x) asm volatile("":"+v"(x))
  #define MX3(a,b,c) __builtin_fmaxf(__builtin_fmaxf((a),(b)),(c))
  #define GAPA(MF,A0,A1,A2,A3,W0,W1,PW) do{ MF; sacc+=A0; sacc+=A1; sacc+=A2; sacc+=A3; PIN(sacc); W0; W1; PIN(PW); SBAR(); }while(0)
  #define EX(v) __builtin_amdgcn_exp2f(v)
  #define GAPB(MF,X,B) do{ MF; X[B]=EX(X[B]); X[B+1]=EX(X[B+1]); PIN(X); SBAR(); }while(0)
  #define VOFF(f) ((2*((f)>>3)+((f)&1))*4096+(((f)&7)>>1)*1024)
  #define VRDW(f) do{ vlo[(f)&3]=vtr(vp_+VOFF(f)); vhi[(f)&3]=vtr(vp_+VOFF(f)+512); }while(0)
  #define KRD(G,j) do{ if(G){ kload2(kf,kp0+sl_next,j); SBAR(); } }while(0)
  #define STEP(C0,C1,P0,P1,t,GK,GV,GL) do{ SBAR(); \
    const lds_cptr vp_=vp0+2*sl_prev; \
    VRDW(0); SBAR(); float sacc=(P0[0]+P0[1]); \
    GAPA(C0=__builtin_amdgcn_mfma_f32_32x32x16_bf16(kf[0],qr[0],f32x16{},0,0,0), P0[2],P0[3],P0[4],P0[5],     pw0[0]=PKW(P0,0), pw0[1]=PKW(P0,2), pw0); \
    VRDW(1); SBAR(); GAPA(C1=__builtin_amdgcn_mfma_f32_32x32x16_bf16(kf[1],qr[0],f32x16{},0,0,0), P0[6],P0[7],P0[8],P0[9],     pw0[2]=PKW(P0,4), pw0[3]=PKW(P0,6), pw0); \
    VRDW(2); SBAR(); GAPA(C0=__builtin_amdgcn_mfma_f32_32x32x16_bf16(kf[2],qr[1],C0,0,0,0),   P0[10],P0[11],P0[12],P0[13], pw1[0]=PKW(P0,8), pw1[1]=PKW(P0,10), pw1); \
    VRDW(3); SBAR(); GAPA(C1=__builtin_amdgcn_mfma_f32_32x32x16_bf16(kf[3],qr[1],C1,0,0,0),   P0[14],P0[15],P1[0],P1[1],   pw1[2]=PKW(P0,12),pw1[3]=PKW(P0,14), pw1); \
    GAPA(C0=__builtin_amdgcn_mfma_f32_32x32x16_bf16(kf[4],qr[2],C0,0,0,0),   P1[2],P1[3],P1[4],P1[5],     pw2[0]=PKW(P1,0), pw2[1]=PKW(P1,2), pw2); \
    GAPA(C1=__builtin_amdgcn_mfma_f32_32x32x16_bf16(kf[5],qr[2],C1,0,0,0),   P1[6],P1[7],P1[8],P1[9],     pw2[2]=PKW(P1,4), pw2[3]=PKW(P1,6), pw2); \
    GAPA(C0=__builtin_amdgcn_mfma_f32_32x32x16_bf16(kf[6],qr[3],C0,0,0,0),   P1[10],P1[11],P1[12],P1[13], pw3[0]=PKW(P1,8), pw3[1]=PKW(P1,10), pw3); \
    GAPA(C1=__builtin_amdgcn_mfma_f32_32x32x16_bf16(kf[7],qr[3],C1,0,0,0),   P1[14],P1[15],0.f,0.f,       pw3[2]=PKW(P1,12),pw3[3]=PKW(P1,14), pw3); \
    l_reg+=sacc; \
    _Pragma("unroll") for(int r=0;r<16;++r){C0[r]-=mhat;C1[r]-=mhat;} \
    if(GK){DMA_K((t)+3,sl_cur);} if(GV){DMA_V((t)+1,sl_next);} \
    CMASK(C0,C1,t); \
    { float a=MX3(C0[0],C0[1],C1[0]),b=MX3(C0[2],C0[3],C1[1]); a=MX3(a,C1[2],C1[3]); \
      _Pragma("unroll") for(int r=4;r<16;r+=4){a=MX3(a,C0[r],C0[r+1]);b=MX3(b,C0[r+2],C0[r+3]);a=MX3(a,C1[r],C1[r+1]);b=MX3(b,C1[r+2],C1[r+3]);} \
      float rm=__builtin_fmaxf(a,b); { auto rr=__builtin_amdgcn_permlane32_swap(__float_as_uint(rm),__float_as_uint(rm),false,false); rm=__builtin_fmaxf(__uint_as_float(rr[0]),__uint_as_float(rr[1])); } \
      resc=false; \
      if(__builtin_expect(__any(rm>(float)THRL),0)){ const float dl=__builtin_fmaxf(rm,0.f); mhat+=dl; \
        _Pragma("unroll") for(int r=0;r<16;++r){C0[r]-=dl;C1[r]-=dl;} \
        const float f=__builtin_amdgcn_exp2f(-dl); l_reg*=f; if(hi==0)wsf[r32]=f; resc=true; } } \
    SBAR(); \
    GAPB(o[0]=__builtin_amdgcn_mfma_f32_32x32x16_bf16(PAF(0),VFRW(0),o[0],0,0,0), C0,0);  VRDW(4);  SBAR(); \
    GAPB(o[1]=__builtin_amdgcn_mfma_f32_32x32x16_bf16(PAF(0),VFRW(1),o[1],0,0,0), C0,2);  VRDW(5);  SBAR(); \
    KRD(GL,0); GAPB(o[0]=__builtin_amdgcn_mfma_f32_32x32x16_bf16(PAF(1),VFRW(2),o[0],0,0,0), C0,4);  VRDW(6);  SBAR(); \
    KRD(GL,1); GAPB(o[1]=__builtin_amdgcn_mfma_f32_32x32x16_bf16(PAF(1),VFRW(3),o[1],0,0,0), C0,6);  VRDW(7);  SBAR(); \
    KRD(GL,2); GAPB(o[0]=__builtin_amdgcn_mfma_f32_32x32x16_bf16(PAF(2),VFRW(0),o[0],0,0,0), C0,8);  VRDW(8);  SBAR(); \
    KRD(GL,3); GAPB(o[1]=__builtin_amdgcn_mfma_f32_32x32x16_bf16(PAF(2),VFRW(1),o[1],0,0,0), C0,10); VRDW(9);  SBAR(); \
    GAPB(o[0]=__builtin_amdgcn_mfma_f32_32x32x16_bf16(PAF(3),VFRW(2),o[0],0,0,0), C0,12); VRDW(10); SBAR(); \
    GAPB(o[1]=__builtin_amdgcn_mfma_f32_32x32x16_bf16(PAF(3),VFRW(3),o[1],0,0,0), C0,14); VRDW(11); SBAR(); \
    GAPB(o[2]=__builtin_amdgcn_mfma_f32_32x32x16_bf16(PAF(0),VFRW(0),o[2],0,0,0), C1,0);  VRDW(12); SBAR(); \
    GAPB(o[3]=__builtin_amdgcn_mfma_f32_32x32x16_bf16(PAF(0),VFRW(1),o[3],0,0,0), C1,2);  VRDW(13); SBAR(); \
    GAPB(o[2]=__builtin_amdgcn_mfma_f32_32x32x16_bf16(PAF(1),VFRW(2),o[2],0,0,0), C1,4);  VRDW(14); SBAR(); \
    GAPB(o[3]=__builtin_amdgcn_mfma_f32_32x32x16_bf16(PAF(1),VFRW(3),o[3],0,0,0), C1,6);  VRDW(15); SBAR(); \
    GAPB(o[2]=__builtin_amdgcn_mfma_f32_32x32x16_bf16(PAF(2),VFRW(0),o[2],0,0,0), C1,8); \
    GAPB(o[3]=__builtin_amdgcn_mfma_f32_32x32x16_bf16(PAF(2),VFRW(1),o[3],0,0,0), C1,10); \
    GAPB(o[2]=__builtin_amdgcn_mfma_f32_32x32x16_bf16(PAF(3),VFRW(2),o[2],0,0,0), C1,12); \
    GAPB(o[3]=__builtin_amdgcn_mfma_f32_32x32x16_bf16(PAF(3),VFRW(3),o[3],0,0,0), C1,14); \
    }while(0)
  int t=1;
  #undef CMASK
  #define CMASK(P0,P1,t) do{}while(0)
  for(;t+5<NT;t+=2){
    STEP(pB0,pB1,pA0,pA1,t,true,true,true);     WAIT_BAR(3); RESC(); ROT();
    STEP(pA0,pA1,pB0,pB1,t+1,true,true,true);   WAIT_BAR(3); RESC(); ROT();
  }
  #undef CMASK
  #define CMASK(P0,P1,t) do{int jb_=(t)-(NT-4); if(jb_>=0)cmask(P0,P1,jb_,qrel,hi);}while(0)
  #define ENDW(tt) do{ if((tt)+3<NT){WAIT_BAR(3);} else if((tt)+2<NT){WAIT_BAR(2);} else {WAIT_BAR(0);} }while(0)
  for(;t+1<NT;t+=2){
    STEP(pB0,pB1,pA0,pA1,t,(t+3<NT),(t+1<NT),(t+1<NT));       ENDW(t);   RESC(); ROT();
    STEP(pA0,pA1,pB0,pB1,t+1,(t+4<NT),(t+2<NT),(t+2<NT));     ENDW(t+1); RESC(); ROT();
  }
  STEP(pB0,pB1,pA0,pA1,NT-1,false,false,false); RESC();
  { float sacc=pB0[0]+pB0[1]; _Pragma("unroll") for(int r=2;r<16;++r)sacc+=pB0[r]; _Pragma("unroll") for(int r=0;r<16;++r)sacc+=pB1[r]; l_reg+=sacc;
    pw0=(u32x4){PKW(pB0,0),PKW(pB0,2),PKW(pB0,4),PKW(pB0,6)};pw1=(u32x4){PKW(pB0,8),PKW(pB0,10),PKW(pB0,12),PKW(pB0,14)};pw2=(u32x4){PKW(pB1,0),PKW(pB1,2),PKW(pB1,4),PKW(pB1,6)};pw3=(u32x4){PKW(pB1,8),PKW(pB1,10),PKW(pB1,12),PKW(pB1,14)};
    SBAR(); pv(o,vb0+2*sl_cur,PAF(0),PAF(1),PAF(2),PAF(3)); }
  #undef PKW
  #undef PAF
  #undef VFRW
  #undef VOFF
  #undef PIN
  #undef MX3
  #undef GAPA
  #undef GAPB
  #undef EX
  #undef VRDW
  #undef KRD
  #undef STEP
  #undef ENDW
  {auto rr=__builtin_amdgcn_permlane32_swap(__float_as_uint(l_reg),__float_as_uint(l_reg),false,false);l_reg=__uint_as_float(rr[0])+__uint_as_float(rr[1]);}
  if(hi==0)wsf[32+r32]=l_reg;asm volatile("s_waitcnt lgkmcnt(0)":::"memory");
  float rli[16];
  #pragma unroll
  for(int r=0;r<16;++r)rli[r]=__builtin_amdgcn_rcpf(wsf[32+crow(r,hi)]);
  bf16*Ow=O+(rowbase+q0+wid*QBLK)*OPITCH;
  { bf16*stg=(bf16*)(shm+LDS_OST)+wid*4096;
    #pragma unroll
    for(int r=0;r<16;++r){const int orow=crow(r,hi);
      #pragma unroll
      for(int d0=0;d0<4;++d0)stg[orow*128+d0*32+r32]=__float2bfloat16(o[d0][r]*rli[r]);}
    asm volatile("s_waitcnt lgkmcnt(0)":::"memory");
    #pragma unroll
    for(int i=0;i<8;++i){const int row=i*4+(lane>>4),ch=lane&15; const u32x4 v=*(const u32x4*)(stg+row*128+ch*8); ATTN_STORE16(Ow+(long)row*OPITCH+ch*8,v);} }
  asm volatile("s_waitcnt lgkmcnt(0)\n\ts_barrier":::"memory");
  #undef DMA_K
  #undef DMA_V
  #undef CMASK
  #undef START
  #undef RESC
  #undef ROT
}
constexpr int ATTN_LDS_BYTES=LDS_BYTES;
#undef SBAR
#undef WAIT_BAR
}
#define LAS __attribute__((address_space(3)))
typedef unsigned short bf16;
typedef unsigned u32x4 __attribute__((ext_vector_type(4)));
typedef unsigned u32x2 __attribute__((ext_vector_type(2)));
typedef float f32x4 __attribute__((ext_vector_type(4)));
typedef float f32x2 __attribute__((ext_vector_type(2)));
typedef float f32x16 __attribute__((ext_vector_type(16)));
typedef short bf16x8 __attribute__((ext_vector_type(8)));
typedef __bf16 bf16x2_t __attribute__((ext_vector_type(2)));

constexpr int NWAVES = 8, NTHR = 512;
constexpr int MT = 16384, DMOD = 2048, SEQL = 4096, IN0W = 7168;
constexpr float EPS = 1e-6f;
constexpr size_t MiB = 1u << 20;
constexpr size_t WS_LAM32 = 64 * 1024;
constexpr size_t WS_R0 = 192 * 1024;
constexpr size_t WS_SUMSQ = 128 * 1024, WS_ZERO_BYTES = 192 * 1024;
constexpr size_t WS_ROT = 1 * MiB;
constexpr size_t WS_WIN0 = 2 * MiB, WS_WOUT0 = 30 * MiB, WS_WIN1 = 38 * MiB, WS_WGLU = 54 * MiB, WS_WOUT1 = 62 * MiB;
constexpr size_t WS_TF = 70 * MiB, WS_WF = 74 * MiB, WS_VF = 90 * MiB;
constexpr size_t WS_H = 112 * MiB;
constexpr size_t WS_PROJ = 176 * MiB;
constexpr size_t WS_UGM = 176 * MiB, WS_GATE = 240 * MiB, WS_Z = 304 * MiB;
constexpr size_t WS_CAT = 400 * MiB;
constexpr size_t WS_OUT2 = 432 * MiB, WS_END = 496 * MiB;
constexpr int RING_BYTES = 131072, LDS_BYTES = 163840, MISC_OFF = LDS_BYTES - 512;
constexpr int NPH = 11;

__device__ __forceinline__ unsigned pkbf(float lo, float hi) { f32x2 v = {lo, hi}; bf16x2_t b = __builtin_convertvector(v, bf16x2_t); return __builtin_bit_cast(unsigned, b); }
__device__ __forceinline__ float bflo(unsigned u) { return __uint_as_float(u << 16); }
__device__ __forceinline__ float bfhi(unsigned u) { return __uint_as_float(u & 0xffff0000u); }
__device__ __forceinline__ float sigm(float x) { return __builtin_amdgcn_rcpf(1.0f + __expf(-x)); }
__device__ __forceinline__ float siluf(float x) { return x * sigm(x); }
__device__ __forceinline__ float gelu_tanh(float x) { return x * sigm(1.5957691216057308f * (x + 0.044715f * x * x * x)); }
__device__ __forceinline__ float wave_sum(float v) {
#pragma unroll
    for (int o = 1; o < 64; o <<= 1) v += __shfl_xor(v, o);
    return v;
}
__device__ __forceinline__ int crow(int r, int hi) { return (r & 3) + 8 * (r >> 2) + 4 * hi; }
__device__ __forceinline__ float red_frac(double th) { const double rev = th * 0.15915494309189535; return (float)(rev - rint(rev)); }
__device__ __forceinline__ float red_angle(double th) { const double rev = th * 0.15915494309189535; const double fr = rev - rint(rev); return (float)(fr * 6.283185307179586); }

typedef __attribute__((address_space(1))) unsigned gu32;
#define XB_TMO      128
#define XB_XCNT(j)  (256  + 64 * (j))
#define XB_XSUB(j)  (1280 + 64 * (j))
#define XB_XGEN(j)  (2304 + 64 * (j))
#define XB_TOP      3328
#define XB_TOPGEN   3392
#define XCD_BAR_WORDS 3456
#define XB_SPIN_CAP (1u << 18)

__device__ __forceinline__ unsigned xb_ld(unsigned* p)              { return __hip_atomic_load(p, __ATOMIC_RELAXED, __HIP_MEMORY_SCOPE_AGENT); }
__device__ __forceinline__ unsigned xb_add(unsigned* p, unsigned v) { return __hip_atomic_fetch_add(p, v, __ATOMIC_RELAXED, __HIP_MEMORY_SCOPE_AGENT); }
__device__ __forceinline__ unsigned xb_xcc_id() { return (unsigned)__builtin_amdgcn_s_getreg((3 << 11) | 20) & 0xFu; }
#define XB_SPIN(cond, bar) do { unsigned _sp = 0; while (cond) { __builtin_amdgcn_s_sleep(1); \
    if ((++_sp & 255u) == 0u) { if (xb_ld(&(bar)[XB_TMO])) break; if (_sp > XB_SPIN_CAP) { atomicAdd(&(bar)[XB_TMO], 1u); break; } } } } while (0)

struct XcdBarrier {
    unsigned* bar; unsigned x;
    volatile LAS unsigned* st;
};

__device__ __forceinline__ XcdBarrier xcd_barrier_post(unsigned* bar, volatile LAS unsigned* st) {
    XcdBarrier b; b.bar = bar; b.x = xb_xcc_id(); b.st = st;
    if (threadIdx.x == 0) (void)xb_add(&bar[XB_XCNT(b.x)], 1u);
    return b;
}
__device__ __forceinline__ void xcd_barrier_complete(unsigned* bar, unsigned x, unsigned& nloc, unsigned& nx) {
    const unsigned G = gridDim.x * gridDim.y * gridDim.z;
    unsigned sum, cnt, mine, sp = 0u;
    for (;;) {
        sum = 0u; cnt = 0u; mine = 0u;
#pragma unroll
        for (unsigned j = 0; j < 16; ++j) { const unsigned c = xb_ld(&bar[XB_XCNT(j)]); sum += c; cnt += (c > 0u) ? 1u : 0u; mine = (j == x) ? c : mine; }
        if (sum == G) break;
        __builtin_amdgcn_s_sleep(1);
        if ((++sp & 255u) == 0u) { if (xb_ld(&bar[XB_TMO])) break; if (sp > XB_SPIN_CAP) { atomicAdd(&bar[XB_TMO], 1u); break; } }
    }
    nloc = mine > 0u ? mine : 1u; nx = cnt > 0u ? cnt : 1u;
}

__device__ __forceinline__ void xcd_barrier(const XcdBarrier& b) {
    asm volatile("s_waitcnt vmcnt(0)" ::: "memory");
    __syncthreads();
    if (threadIdx.x == 0) {
        unsigned* bar = b.bar;
        __builtin_amdgcn_s_waitcnt(0);
        unsigned nloc = b.st[0], nx = b.st[1];
        if (nloc == 0u) { xcd_barrier_complete(bar, b.x, nloc, nx); b.st[0] = nloc; b.st[1] = nx; }
        const unsigned old = xb_add(&bar[XB_XSUB(b.x)], 1u);
        const unsigned gen = old / nloc;
        if (old + 1u == (gen + 1u) * nloc) {
            __builtin_amdgcn_fence(__ATOMIC_RELEASE, "agent");
            asm volatile("s_waitcnt vmcnt(0)" ::: "memory");
            const unsigned og = xb_add(&bar[XB_TOP], 1u);
            const unsigned tg = og / nx;
            if (og + 1u == (tg + 1u) * nx) xb_add(&bar[XB_TOPGEN], 1u);
            else XB_SPIN(xb_ld(&bar[XB_TOPGEN]) == tg, bar);
            __builtin_amdgcn_fence(__ATOMIC_ACQUIRE, "agent");
            xb_add(&bar[XB_XGEN(b.x)], 1u);
            asm volatile("s_waitcnt vmcnt(0)" ::: "memory");
        } else {
            XB_SPIN(xb_ld(&bar[XB_XGEN(b.x)]) == gen, bar);
            __builtin_amdgcn_fence(__ATOMIC_ACQUIRE, "agent");
            asm volatile("s_waitcnt vmcnt(0)" ::: "memory");
        }
    }
    __syncthreads();
}

struct Args { const float* in[28]; float* out; unsigned char* ws; int ph_lo, ph_hi, mask, pad; };

__device__ __forceinline__ void p0_transpose_item(const float* W, int K, int N, bf16* WT, LAS float* scr, int item, int lane, const float* gk = nullptr, bool glu_perm = false) {
    const int nblk = N / 32, kb = item / nblk, nb = item % nblk, k0 = 64 * kb, n0 = 32 * nb;
    float tv[32];
#pragma unroll
    for (int i = 0; i < 32; ++i) tv[i] = W[(size_t)(k0 + 2 * i + (lane >> 5)) * N + n0 + (lane & 31)];
    if (gk) {
#pragma unroll
        for (int i = 0; i < 32; ++i) tv[i] *= gk[k0 + 2 * i + (lane >> 5)]; }
#pragma unroll
    for (int i = 0; i < 32; ++i) scr[(2 * i + (lane >> 5)) * 33 + (lane & 31)] = tv[i];
    asm volatile("s_waitcnt lgkmcnt(0)" ::: "memory");
    const int c = lane & 7;
#pragma unroll
    for (int j = 0; j < 4; ++j) { const int n = (lane >> 3) + 8 * j; const LAS float* s = scr + (8 * c) * 33 + n;
        u32x4 o; o.x = pkbf(s[0 * 33], s[1 * 33]); o.y = pkbf(s[2 * 33], s[3 * 33]); o.z = pkbf(s[4 * 33], s[5 * 33]); o.w = pkbf(s[6 * 33], s[7 * 33]);
        const int nb0 = !glu_perm || n0 >= 2048 ? n0 : (n0 < 1024 ? 256 * (n0 >> 7) + (n0 & 127) : 256 * ((n0 - 1024) >> 7) + 128 + (n0 & 127));
        *(u32x4*)(WT + (size_t)(nb0 + n) * K + k0 + 8 * c) = o; }
    asm volatile("s_waitcnt lgkmcnt(0)" ::: "memory");
}
__device__ __forceinline__ void row_to_bf16_rs(const float* xrow, bf16* orow, float* rs, int lane) {
    const f32x4* xr = (const f32x4*)xrow + lane;
    f32x4 v[8]; float s = 0.f;
#pragma unroll
    for (int j = 0; j < 8; ++j) { v[j] = xr[64 * j]; s += (v[j].x * v[j].x + v[j].y * v[j].y) + (v[j].z * v[j].z + v[j].w * v[j].w); }
    const float r = 1.0f / sqrtf(wave_sum(s) * (1.0f / DMOD) + EPS);
    if (lane == 0) *rs = r;
    u32x2* o8 = (u32x2*)orow + lane;
#pragma unroll
    for (int j = 0; j < 8; ++j) { u32x2 w; w.x = pkbf(v[j].x, v[j].y); w.y = pkbf(v[j].z, v[j].w); o8[64 * j] = w; }
}
__device__ __forceinline__ void s5_tables(const Args& a, LAS unsigned char* lds, int g, int part, int tid) {
    LAS float* POWr = (LAS float*)lds;
    LAS float* POWi = POWr + 33 * 64;
    LAS float* BBr = POWi + 33 * 64;
    LAS float* BBi = BBr + 1024;
    LAS float* Cr = BBi + 1024;
    LAS float* Ci = Cr + 1024;
    LAS float* KL = Ci + 1024;
    const float* a_re = a.in[17] + g * 64; const float* a_im = a.in[18] + g * 64;
    const float dt = expf(a.in[19][g]);
    for (int idx = tid; idx < 33 * 64; idx += NTHR) { const int k = idx >> 6, p = idx & 63;
        const float ar = a_re[p], ai = a_im[p]; const float mag = expf(ar * dt * (float)k);
        const float fr = red_frac((double)ai * (double)dt * (double)k);
        POWr[idx] = mag * __builtin_amdgcn_cosf(fr); POWi[idx] = mag * __builtin_amdgcn_sinf(fr); }
    for (int idx = tid; idx < 1024; idx += NTHR) { const int p = idx >> 4;
        const float ar = a_re[p], ai = a_im[p];
        const float em1 = expm1f(ar * dt); const float ang = red_angle((double)ai * (double)dt);
        const float sn = sinf(ang), cs = cosf(ang), sh = sinf(0.5f * ang);
        const float nr = em1 * cs - 2.0f * sh * sh, ni = (em1 + 1.0f) * sn;
        const float den = ar * ar + ai * ai; const float fr = (nr * ar + ni * ai) / den, fi = (ni * ar - nr * ai) / den;
        const float br = a.in[20][(size_t)g * 1024 + idx], bi = a.in[21][(size_t)g * 1024 + idx];
        BBr[idx] = fr * br - fi * bi; BBi[idx] = fr * bi + fi * br;
        Cr[idx] = a.in[22][(size_t)g * 1024 + idx]; Ci[idx] = a.in[23][(size_t)g * 1024 + idx]; }
    __syncthreads();
    if (part == 0) {
        const int lag = tid >> 4, m = tid & 15; float acc[16];
#pragma unroll
        for (int q = 0; q < 16; ++q) acc[q] = 0.f;
        for (int p = 0; p < 64; ++p) { const float cr = Cr[m * 64 + p], ci = Ci[m * 64 + p], pr = POWr[lag * 64 + p], pi = POWi[lag * 64 + p];
            const float gr = cr * pr - ci * pi, gi = cr * pi + ci * pr;
#pragma unroll
            for (int q4 = 0; q4 < 4; ++q4) { const f32x4 b_r = *(const LAS f32x4*)(BBr + p * 16 + 4 * q4), b_i = *(const LAS f32x4*)(BBi + p * 16 + 4 * q4);
#pragma unroll
                for (int e = 0; e < 4; ++e) acc[4 * q4 + e] += gr * b_r[e] - gi * b_i[e]; } }
#pragma unroll
        for (int q = 0; q < 16; ++q) KL[(lag * 16 + m) * 16 + q] = acc[q];
    }
    __syncthreads();
    bf16* TF = (bf16*)(a.ws + WS_TF) + (size_t)g * 32 * 64 * 8;
    if (part == 0) for (int idx = tid; idx < 32 * 64; idx += NTHR) { const int dd = idx >> 6, lane = idx & 63, n = lane & 31, kh = lane >> 5; const int lag = dd - 1 + (n >> 4), m = n & 15;
        float v[8];
#pragma unroll
        for (int j = 0; j < 8; ++j) v[j] = (lag >= 0 && lag < 32) ? KL[(lag * 16 + m) * 16 + 8 * kh + j] : 0.f;
        u32x4 w; w.x = pkbf(v[0], v[1]); w.y = pkbf(v[2], v[3]); w.z = pkbf(v[4], v[5]); w.w = pkbf(v[6], v[7]);
        *(u32x4*)(TF + (size_t)idx * 8) = w; }
    bf16* WF = (bf16*)(a.ws + WS_WF) + (size_t)g * 32 * 4 * 64 * 8;
    if (part == 1) for (int idx = tid; idx < 32 * 4 * 64; idx += NTHR) { const int sp = idx >> 8, nt = (idx >> 6) & 3, lane = idx & 63, n = lane & 31, kh = lane >> 5;
        const int pp = 32 * nt + n, p = pp & 63, comp = pp >> 6, k = 31 - sp; const float pr = POWr[k * 64 + p], pi = POWi[k * 64 + p];
        float v[8];
#pragma unroll
        for (int j = 0; j < 8; ++j) { const float br = BBr[p * 16 + 8 * kh + j], bi = BBi[p * 16 + 8 * kh + j]; v[j] = comp ? (pr * bi + pi * br) : (pr * br - pi * bi); }
        u32x4 w; w.x = pkbf(v[0], v[1]); w.y = pkbf(v[2], v[3]); w.z = pkbf(v[4], v[5]); w.w = pkbf(v[6], v[7]);
        *(u32x4*)(WF + (size_t)idx * 8) = w; }
    bf16* VF = (bf16*)(a.ws + WS_VF) + (size_t)g * 16 * 8 * 64 * 8;
    if (part == 1) for (int idx = tid; idx < 16 * 8 * 64; idx += NTHR) { const int jt = idx >> 9, kk = (idx >> 6) & 7, lane = idx & 63, n = lane & 31, kh = lane >> 5;
        const int s = 2 * jt + (n >> 4), m = n & 15;
        float v[8];
#pragma unroll
        for (int j = 0; j < 8; ++j) { const int pp = 16 * kk + 8 * kh + j, p = pp & 63, comp = pp >> 6;
            const float pr = POWr[(s + 1) * 64 + p], pi = POWi[(s + 1) * 64 + p], cr = Cr[m * 64 + p], ci = Ci[m * 64 + p];
            v[j] = comp ? -(cr * pi + ci * pr) : (cr * pr - ci * pi); }
        u32x4 w; w.x = pkbf(v[0], v[1]); w.y = pkbf(v[2], v[3]); w.z = pkbf(v[4], v[5]); w.w = pkbf(v[6], v[7]);
        *(u32x4*)(VF + (size_t)idx * 8) = w; }
    if (part == 0 && tid < 64) { f32x2* L = (f32x2*)(a.ws + WS_LAM32) + g * 64 + tid; *L = (f32x2){POWr[32 * 64 + tid], POWi[32 * 64 + tid]}; }
    __syncthreads();
}

__device__ __forceinline__ void p0_prologue(const Args& a, LAS unsigned char* lds, int tid, int lane, int wave, int G) {
    if (a.mask & 4) for (int it = blockIdx.x; it < 256; it += G) s5_tables(a, lds, it & 127, it >> 7, tid);
    if (a.mask & 8) {
        f32x2* ROT = (f32x2*)(a.ws + WS_ROT);
        for (int idx = blockIdx.x * NTHR + tid; idx < SEQL * 32; idx += G * NTHR) { const int pos = idx >> 5, i = idx & 31;
            const float freq = exp2f(-(float)i * (13.287712379549449f / 32.0f));
            const float ang = red_angle((double)pos * (double)freq);
            ROT[idx] = (f32x2){cosf(ang), sinf(ang)}; }
    }
    LAS float* scr = (LAS float*)(lds + wave * 16384);
    const int gw = blockIdx.x * NWAVES + wave, NGW = G * NWAVES;
    constexpr int I0 = 32 * (IN0W / 32), I1 = 32 * (2048 / 32), I2 = 32 * (4096 / 32);
    constexpr int NITEMS = I0 + I1 + I2 + I1 + I1;
    if (a.mask & 16) for (int it = gw; it < NITEMS; it += NGW) {
        int r = it;
        if (r < I0) { p0_transpose_item(a.in[2], 2048, IN0W, (bf16*)(a.ws + WS_WIN0), scr, r, lane, a.in[1], true); continue; } r -= I0;
        if (r < I1) { p0_transpose_item(a.in[14], 2048, 2048, (bf16*)(a.ws + WS_WOUT0), scr, r, lane); continue; } r -= I1;
        if (r < I2) { p0_transpose_item(a.in[16], 2048, 4096, (bf16*)(a.ws + WS_WIN1), scr, r, lane, a.in[15]); continue; } r -= I2;
        if (r < I1) { p0_transpose_item(a.in[25], 2048, 2048, (bf16*)(a.ws + WS_WGLU), scr, r, lane); continue; } r -= I1;
        p0_transpose_item(a.in[27], 2048, 2048, (bf16*)(a.ws + WS_WOUT1), scr, r, lane);
    }
    if (a.mask & 32) for (int m = gw; m < MT; m += NGW) row_to_bf16_rs(a.in[0] + (size_t)m * DMOD, (bf16*)(a.ws + WS_H) + (size_t)m * DMOD, (float*)(a.ws + WS_R0) + m, lane);
}

struct QKIn { u32x4 x[4]; f32x4 rot[4]; };
__device__ __forceinline__ void qk_load(QKIn& in, const Args& a, int row, int lane) {
    const bf16* base = (const bf16*)(a.ws + WS_PROJ) + (size_t)row * IN0W + 3072 + (lane >> 2) * 64 + (lane & 3) * 8;
    in.x[0] = *(const u32x4*)base; in.x[1] = *(const u32x4*)(base + 32); in.x[2] = *(const u32x4*)(base + 1024); in.x[3] = *(const u32x4*)(base + 1024 + 32);
    const f32x4* rot = (const f32x4*)((const f32x2*)(a.ws + WS_ROT) + (row & (SEQL - 1)) * 32 + (lane & 3) * 8);
#pragma unroll
    for (int q = 0; q < 4; ++q) in.rot[q] = rot[q];
}
__device__ __forceinline__ void qk_finish(const QKIn& in, const Args& a, int row, int lane) {
    float gq[16], gk[16]; { const int i0 = (lane & 3) * 8;
#pragma unroll
        for (int j = 0; j < 8; ++j) { gq[j] = a.in[7][i0 + j]; gq[8 + j] = a.in[7][32 + i0 + j]; gk[j] = a.in[8][i0 + j]; gk[8 + j] = a.in[8][32 + i0 + j]; } }
    bf16* base = (bf16*)(a.ws + WS_PROJ) + (size_t)row * IN0W + 3072 + (lane >> 2) * 64 + (lane & 3) * 8;
#pragma unroll
    for (int which = 0; which < 2; ++which) { const u32x4 x1 = in.x[2 * which], x2 = in.x[2 * which + 1];
        float f1[8], f2[8]; float ss = 0.f;
#pragma unroll
        for (int q = 0; q < 4; ++q) { f1[2 * q] = bflo(x1[q]); f1[2 * q + 1] = bfhi(x1[q]); f2[2 * q] = bflo(x2[q]); f2[2 * q + 1] = bfhi(x2[q]); }
#pragma unroll
        for (int j = 0; j < 8; ++j) ss += f1[j] * f1[j] + f2[j] * f2[j];
        ss += __shfl_xor(ss, 1); ss += __shfl_xor(ss, 2);
        const float sc = __builtin_amdgcn_rsqf(ss * (1.0f / 64.0f) + EPS) * (which == 0 ? 0.125f * 1.4426950408889634f : 1.0f);
        float o1[8], o2[8];
#pragma unroll
        for (int j = 0; j < 8; ++j) { const float y1 = f1[j] * sc * (which == 0 ? gq[j] : gk[j]), y2 = f2[j] * sc * (which == 0 ? gq[8 + j] : gk[8 + j]);
            const float cs = in.rot[j >> 1][2 * (j & 1)], sn = in.rot[j >> 1][2 * (j & 1) + 1];
            o1[j] = y1 * cs - y2 * sn; o2[j] = y2 * cs + y1 * sn; }
        u32x4 w1, w2;
#pragma unroll
        for (int q = 0; q < 4; ++q) { w1[q] = pkbf(o1[2 * q], o1[2 * q + 1]); w2[q] = pkbf(o2[2 * q], o2[2 * q + 1]); }
        *(u32x4*)(base + which * 1024) = w1; *(u32x4*)(base + which * 1024 + 32) = w2; }
}
__device__ __forceinline__ void mixer_a_unit(const Args& a, LAS unsigned char* lds, int unit, int tid, int lane, int wave, int qrow) {
    const int t0 = unit * 32, s0 = t0 & (SEQL - 1);
    const bf16* PROJ = (const bf16*)(a.ws + WS_PROJ);
    QKIn qin[2];
    if (qrow >= 0) { qk_load(qin[0], a, qrow, lane); qk_load(qin[1], a, qrow + 1, lane); }
#pragma unroll 8
    for (int idx = tid; idx < 62 * 128; idx += NTHR) { const int r = idx >> 7, ch = (idx & 127) * 8; u32x4 w = {0u, 0u, 0u, 0u};
        if (s0 - 30 + r >= 0) w = *(const u32x4*)(PROJ + (size_t)(t0 - 30 + r) * IN0W + ch);
        *(LAS u32x4*)(lds + r * 2048 + ch * 2) = w; }
    if (qrow >= 0) { qk_finish(qin[0], a, qrow, lane); __builtin_amdgcn_sched_barrier(0); qk_finish(qin[1], a, qrow + 1, lane); __builtin_amdgcn_sched_barrier(0); }
    __syncthreads();
    {
        f32x2 P[31], w[31];
        const f32x2 cb = *(const f32x2*)(a.in[4] + 2 * tid);
        const float* wp = a.in[3] + 2 * tid; asm volatile("" : "+v"(wp));
#pragma unroll
        for (int j = 0; j < 31; ++j) { P[j] = cb; w[j] = *(const f32x2*)(wp + j * 1024); }
#define CROW(Q, RHO) { const int r = (Q) * 31 + (RHO); const unsigned uw = *(const LAS unsigned*)(lds + r * 2048 + tid * 4); const f32x2 uv = {bflo(uw), bfhi(uw)}; \
        _Pragma("unroll") for (int j = 0; j < 31; ++j) { if ((Q) == 0 ? (j <= (RHO)) : (j >= (RHO))) P[((RHO) - j + 31) % 31] += w[j] * uv; } \
        if (r >= 30) { *(LAS unsigned*)(lds + (r - 30) * 2048 + tid * 4) = pkbf(P[((RHO) + 1) % 31].x, P[((RHO) + 1) % 31].y); P[((RHO) + 1) % 31] = cb; } \
        if (((RHO) & 3) == 3) __builtin_amdgcn_sched_barrier(0); }
#define CROWS(Q) CROW(Q, 0) CROW(Q, 1) CROW(Q, 2) CROW(Q, 3) CROW(Q, 4) CROW(Q, 5) CROW(Q, 6) CROW(Q, 7) CROW(Q, 8) CROW(Q, 9) CROW(Q, 10) CROW(Q, 11) CROW(Q, 12) CROW(Q, 13) CROW(Q, 14) CROW(Q, 15) \
        CROW(Q, 16) CROW(Q, 17) CROW(Q, 18) CROW(Q, 19) CROW(Q, 20) CROW(Q, 21) CROW(Q, 22) CROW(Q, 23) CROW(Q, 24) CROW(Q, 25) CROW(Q, 26) CROW(Q, 27) CROW(Q, 28) CROW(Q, 29) CROW(Q, 30)
        CROWS(0)
        __builtin_amdgcn_sched_barrier(0);
        CROWS(1)
#undef CROWS
#undef CROW
    }
    asm volatile("" ::: "memory"); __builtin_amdgcn_sched_barrier(0);
    if (qrow >= 0) { qk_load(qin[0], a, qrow + 2, lane); qk_load(qin[1], a, qrow + 3, lane); }
    __syncthreads();
    bf16* CAT = (bf16*)(a.ws + WS_CAT);
    {
        u32x4 gt[4][2]; float gg[16], bb[16];
#pragma unroll
        for (int q = 0; q < 4; ++q)
#pragma unroll
            for (int j = 0; j < 2; ++j) gt[q][j] = *(const u32x4*)(PROJ + (size_t)(t0 + wave * 4 + q) * IN0W + 2048 + 512 * j + lane * 8);
#pragma unroll
        for (int j = 0; j < 2; ++j)
#pragma unroll
            for (int e4 = 0; e4 < 2; ++e4) { const f32x4 g4 = *(const f32x4*)(a.in[5] + 512 * j + lane * 8 + 4 * e4), b4 = *(const f32x4*)(a.in[6] + 512 * j + lane * 8 + 4 * e4);
#pragma unroll
                for (int e = 0; e < 4; ++e) { gg[8 * j + 4 * e4 + e] = g4[e]; bb[8 * j + 4 * e4 + e] = b4[e]; } }
#pragma unroll
        for (int q = 0; q < 4; ++q) { const int i = wave * 4 + q; float v[16]; float s = 0.f;
#pragma unroll
            for (int j = 0; j < 2; ++j) { const u32x4 cw = *(const LAS u32x4*)(lds + i * 2048 + (512 * j + lane * 8) * 2);
#pragma unroll
                for (int e = 0; e < 4; ++e) { v[8 * j + 2 * e] = bflo(cw[e]); v[8 * j + 2 * e + 1] = bfhi(cw[e]); } }
            float s2 = 0.f;
#pragma unroll
            for (int e = 0; e < 16; ++e) { s += v[e]; s2 += v[e] * v[e]; }
            const float mean = wave_sum(s) * (1.0f / 1024.0f), ex2 = wave_sum(s2) * (1.0f / 1024.0f);
#pragma unroll
            for (int e = 0; e < 16; ++e) v[e] -= mean;
            const float rstd = __builtin_amdgcn_rsqf(fmaxf(ex2 - mean * mean, 0.f) + EPS);
            const size_t row = (size_t)(t0 + i);
#pragma unroll
            for (int j = 0; j < 2; ++j) { u32x4 o;
#pragma unroll
                for (int e = 0; e < 4; ++e) { const float y0 = v[8 * j + 2 * e] * rstd * gg[8 * j + 2 * e] + bb[8 * j + 2 * e], y1 = v[8 * j + 2 * e + 1] * rstd * gg[8 * j + 2 * e + 1] + bb[8 * j + 2 * e + 1];
                    o[e] = pkbf(siluf(y0) * bflo(gt[q][j][e]), siluf(y1) * bfhi(gt[q][j][e])); }
                *(u32x4*)(CAT + row * DMOD + 512 * j + lane * 8) = o; }
            __builtin_amdgcn_sched_barrier(0); }
    }
    if (qrow >= 0) { qk_finish(qin[0], a, qrow + 2, lane); __builtin_amdgcn_sched_barrier(0); qk_finish(qin[1], a, qrow + 3, lane); }
    __syncthreads();
}
__device__ __forceinline__ void qk_prep_phase(const Args& a, int gw, int NGW, int lane) {
#pragma unroll 1
    for (int r0 = gw * 4; r0 < MT; r0 += NGW * 4) { QKIn in[4];
#pragma unroll
        for (int q = 0; q < 4; ++q) qk_load(in[q], a, r0 + q, lane);
#pragma unroll
        for (int q = 0; q < 4; ++q) { qk_finish(in[q], a, r0 + q, lane); __builtin_amdgcn_sched_barrier(0); } }
}
struct CbIn { u32x4 a0[2], a1[2], bg[2]; };
__device__ __forceinline__ void cb_load(CbIn& in, const Args& a, int row, int lane) {
#pragma unroll
    for (int hg = 0; hg < 2; ++hg) { const int h = hg * 4 + (lane >> 4), j0 = (lane & 15) * 8;
        const bf16* OP = (const bf16*)(a.ws + WS_PROJ) + (size_t)row * IN0W + h * 128 + j0;
        in.a0[hg] = *(const u32x4*)OP; in.a1[hg] = *(const u32x4*)(OP + 1024);
        in.bg[hg] = *(const u32x4*)((const bf16*)(a.ws + WS_PROJ) + (size_t)row * IN0W + 6144 + h * 128 + j0); }
}
__device__ __forceinline__ void cb_finish(const CbIn& in, const Args& a, int row, int lane, float lam, const float (&sg)[8]) {
#pragma unroll
    for (int hg = 0; hg < 2; ++hg) { const int h = hg * 4 + (lane >> 4), j0 = (lane & 15) * 8;
        float o[8]; float ss = 0.f;
#pragma unroll
        for (int q = 0; q < 4; ++q) { o[2 * q] = bflo(in.a0[hg][q]) - lam * bflo(in.a1[hg][q]); o[2 * q + 1] = bfhi(in.a0[hg][q]) - lam * bfhi(in.a1[hg][q]); }
#pragma unroll
        for (int j = 0; j < 8; ++j) ss += o[j] * o[j];
        ss += __shfl_xor(ss, 1); ss += __shfl_xor(ss, 2); ss += __shfl_xor(ss, 4); ss += __shfl_xor(ss, 8);
        const float r = __builtin_amdgcn_rsqf(ss * (1.0f / 128.0f) + EPS) * 0.8f;
        u32x4 w;
#pragma unroll
        for (int q = 0; q < 4; ++q) w[q] = pkbf(o[2 * q] * r * sg[2 * q] * bflo(in.bg[hg][q]), o[2 * q + 1] * r * sg[2 * q + 1] * bfhi(in.bg[hg][q]));
        *(u32x4*)((bf16*)(a.ws + WS_CAT) + (size_t)row * DMOD + 1024 + h * 128 + j0) = w; }
}
__device__ __forceinline__ void combine_phase(const Args& a, int gw, int NGW, int lane, float lam) {
    float sg[8];
#pragma unroll
    for (int j = 0; j < 8; ++j) sg[j] = a.in[13][(lane & 15) * 8 + j];
#pragma unroll 1
    for (int r0 = gw * 4; r0 < MT; r0 += NGW * 4) { CbIn in[4];
#pragma unroll
        for (int q = 0; q < 4; ++q) cb_load(in[q], a, r0 + q, lane);
#pragma unroll
        for (int q = 0; q < 4; ++q) { cb_finish(in[q], a, r0 + q, lane, lam, sg); __builtin_amdgcn_sched_barrier(0); } }
}

constexpr int UPITCH = 1040, HPITCH = 272, S5_UIMG = 0, S5_HIMG = 64 * UPITCH, S5_EBUF = S5_HIMG + 64 * HPITCH, S5_TF = S5_EBUF + 32768, S5_END = S5_TF + 32768;
#define S5_ITEM(step) (bx + ((step) >> 1) * G)
#define S5_USRC(step) ((const u32x4*)((const bf16*)(a.ws + WS_UGM) + ((size_t)(S5_ITEM(step) & 127) * MT + (size_t)(S5_ITEM(step) >> 7) * SEQL + ((step) & 1) * 2048) * 16))
__device__ __forceinline__ void s5_phase(const Args& a, LAS unsigned char* lds, int bx, int G, int tid, int lane, int wave) {
    const int r32 = lane & 31, hi = lane >> 5;
    int nsteps = 0; for (int it = bx; it < 512; it += G) nsteps += 2;
    if (nsteps == 0) return;
    u32x4 upre[8];
    { const u32x4* src = S5_USRC(0);
#pragma unroll
      for (int ps = 0; ps < 8; ++ps) upre[ps] = src[ps * NTHR + tid]; }
    float hr = 0.f, him = 0.f, dsk = 0.f; f32x2 l32 = {0.f, 0.f};
#pragma unroll 1
    for (int step = 0; step < nsteps; ++step) {
        const int item = S5_ITEM(step), g = item & 127, b = item >> 7, half = step & 1;
        const bf16x8* WF = (const bf16x8*)(a.ws + WS_WF) + (size_t)g * 32 * 4 * 64 + lane;
        const bf16x8* VF = (const bf16x8*)(a.ws + WS_VF) + (size_t)g * 16 * 8 * 64 + lane;
#pragma unroll
        for (int ps = 0; ps < 8; ++ps) { const int idx = ps * NTHR + tid; *(LAS u32x4*)(lds + S5_UIMG + (idx >> 6) * UPITCH + (idx & 63) * 16) = upre[ps]; }
        if (half == 0) {
            const u32x4* tsrc = (const u32x4*)(a.ws + WS_TF) + (size_t)g * 2048;
            u32x4 tv[4];
#pragma unroll
            for (int ps = 0; ps < 4; ++ps) tv[ps] = tsrc[ps * NTHR + tid];
            hr = 0.f; him = 0.f; dsk = a.in[24][g * 16 + (r32 & 15)];
            if (wave == 0) l32 = ((const f32x2*)(a.ws + WS_LAM32))[g * 64 + lane];
#pragma unroll
            for (int ps = 0; ps < 4; ++ps) *(LAS u32x4*)(lds + S5_TF + (ps * NTHR + tid) * 16) = tv[ps];
        }
        __syncthreads();
        {
            const int mt = wave >> 2, nt = wave & 3; f32x16 acc = {};
            const LAS unsigned char* ap = lds + S5_UIMG + (32 * mt + r32) * UPITCH + hi * 16;
#pragma unroll 16
            for (int sp = 0; sp < 32; ++sp) { const bf16x8 A = *(const LAS bf16x8*)(ap + sp * 32); const bf16x8 B = WF[(sp * 4 + nt) * 64];
                acc = __builtin_amdgcn_mfma_f32_32x32x16_bf16(A, B, acc, 0, 0, 0); }
            LAS float* E = (LAS float*)(lds + S5_EBUF);
#pragma unroll
            for (int i = 0; i < 16; ++i) E[(32 * mt + crow(i, hi)) * 128 + 32 * nt + r32] = acc[i];
        }
        __syncthreads();
        if (wave == 0) {
            const LAS float* E = (const LAS float*)(lds + S5_EBUF); LAS bf16* H = (LAS bf16*)(lds + S5_HIMG);
#pragma unroll 1
            for (int c0 = 0; c0 < 64; c0 += 8) { float er[8], ei[8];
#pragma unroll
                for (int q = 0; q < 8; ++q) { er[q] = E[(c0 + q) * 128 + lane]; ei[q] = E[(c0 + q) * 128 + 64 + lane]; }
#pragma unroll
                for (int q = 0; q < 8; ++q) { const unsigned pk = pkbf(hr, him); H[(c0 + q) * (HPITCH / 2) + lane] = (bf16)(pk & 0xffffu); H[(c0 + q) * (HPITCH / 2) + 64 + lane] = (bf16)(pk >> 16);
                    const float nr = l32.x * hr - l32.y * him + er[q], ni = l32.x * him + l32.y * hr + ei[q]; hr = nr; him = ni; } }
        }
        __syncthreads();
        f32x16 acc[2][2];
#pragma unroll
        for (int jj = 0; jj < 2; ++jj) { const int j = jj ? 15 - wave : wave; acc[jj][0] = (f32x16){}; acc[jj][1] = (f32x16){};
            bf16x8 vfr[8];
#pragma unroll
            for (int kk = 0; kk < 8; ++kk) vfr[kk] = VF[(j * 8 + kk) * 64];
            const LAS unsigned char* ap = lds + S5_UIMG + r32 * UPITCH + hi * 16; const LAS unsigned char* tp = lds + S5_TF + lane * 16; const int nks = 2 * j + 2;
#pragma unroll 4
            for (int sp = 0; sp < nks; ++sp) { const bf16x8 B = *(const LAS bf16x8*)(tp + (2 * j + 1 - sp) * 1024); const bf16x8 A0 = *(const LAS bf16x8*)(ap + sp * 32), A1 = *(const LAS bf16x8*)(ap + 32 * UPITCH + sp * 32);
                acc[jj][0] = __builtin_amdgcn_mfma_f32_32x32x16_bf16(A0, B, acc[jj][0], 0, 0, 0); acc[jj][1] = __builtin_amdgcn_mfma_f32_32x32x16_bf16(A1, B, acc[jj][1], 0, 0, 0); }
            const LAS unsigned char* hp = lds + S5_HIMG + r32 * HPITCH + hi * 16;
#pragma unroll
            for (int kk = 0; kk < 8; ++kk) { const bf16x8 A0 = *(const LAS bf16x8*)(hp + kk * 32), A1 = *(const LAS bf16x8*)(hp + 32 * HPITCH + kk * 32);
                acc[jj][0] = __builtin_amdgcn_mfma_f32_32x32x16_bf16(A0, vfr[kk], acc[jj][0], 0, 0, 0); acc[jj][1] = __builtin_amdgcn_mfma_f32_32x32x16_bf16(A1, vfr[kk], acc[jj][1], 0, 0, 0); }
        }
        if (step + 1 < nsteps) { const u32x4* src = S5_USRC(step + 1);
#pragma unroll
            for (int ps = 0; ps < 8; ++ps) upre[ps] = src[ps * NTHR + tid]; }
        __syncthreads();
#pragma unroll
        for (int jj = 0; jj < 2; ++jj) { const int j = jj ? 15 - wave : wave;
#pragma unroll
            for (int mt = 0; mt < 2; ++mt)
                { LAS bf16* ub = (LAS bf16*)(lds + S5_UIMG + (32 * mt + 4 * hi) * UPITCH + j * 64 + r32 * 2); unsigned short uu[16];
#pragma unroll
                    for (int i = 0; i < 16; ++i) uu[i] = ub[((i & 3) + 8 * (i >> 2)) * (UPITCH / 2)];
#pragma unroll
                    for (int i = 0; i < 16; ++i) { const float u = __uint_as_float((unsigned)uu[i] << 16); const float v = acc[jj][mt][i] + dsk * u; uu[i] = (unsigned short)(pkbf(gelu_tanh(v), 0.f) & 0xffffu); }
#pragma unroll
                    for (int i = 0; i < 16; ++i) ub[((i & 3) + 8 * (i >> 2)) * (UPITCH / 2)] = uu[i]; } }
        __syncthreads();
        { bf16* Z = (bf16*)(a.ws + WS_Z);
#pragma unroll
          for (int ps = 0; ps < 4; ++ps) { const int idx = ps * NTHR + tid; const LAS unsigned char* sp_ = lds + S5_UIMG + (idx >> 5) * UPITCH + (idx & 31) * 32;
            const u32x4 v0 = *(const LAS u32x4*)sp_, v1 = *(const LAS u32x4*)(sp_ + 16);
            bf16* dst = Z + (size_t)(b * SEQL + half * 2048 + idx) * DMOD + 16 * g; *(u32x4*)dst = v0; *(u32x4*)(dst + 8) = v1; } }
        __syncthreads();
    }
}

#ifndef MK_N_LAUNCHES
#define MK_N_LAUNCHES 1
#endif
__global__ void __launch_bounds__(NTHR, 2) fwd_kernel(Args a) {
    extern __shared__ __attribute__((aligned(16))) unsigned char lds_raw[];
    cg::grid_group grid = cg::this_grid();
    LAS unsigned char* lds = (LAS unsigned char*)lds_raw;
    const int tid = threadIdx.x, lane = tid & 63, wave = __builtin_amdgcn_readfirstlane(tid >> 6), G = gridDim.x;
    const int bx = blockIdx.x; const int vcu = (G % 8 == 0) ? (bx % 8) * (G / 8) + bx / 8 : bx;
    const int gw = bx * NWAVES + wave, NGW = G * NWAVES;
    const int lo = a.ph_lo, hi = a.ph_hi;
    unsigned char* ws = a.ws;
    volatile LAS unsigned* MISC = (volatile LAS unsigned*)(lds + MISC_OFF);
    if (tid < 32) MISC[tid] = 0u;
    __syncthreads();
    XcdBarrier bar = xcd_barrier_post((unsigned*)ws, MISC + 8);
#define IN(k) (lo <= (k) && (k) < hi)
#ifdef PROBE_A
#define STAMP(k) do { if (bx == 0 && tid == 0) ((unsigned long long*)(ws + 32768))[(k)] = __builtin_amdgcn_s_memrealtime(); } while (0)
#else
#define STAMP(k) do {} while (0)
#endif
#define SEAM(k) do { STAMP((k) + 1); if (IN(k) && IN((k) + 1)) { if ((k) == 0) grid.sync(); else xcd_barrier(bar); } } while (0)

    STAMP(0);
    if (IN(0)) { p0_prologue(a, lds, tid, lane, wave, G); }
#if defined(TWICE_P) && TWICE_P == 0
    __syncthreads(); p0_prologue(a, lds, tid, lane, wave, G);
#endif
    SEAM(0);
    if (IN(1)) {
        pg8::Gemm g{(const bf16*)(ws + WS_H), (const bf16*)(ws + WS_WIN0), MT, IN0W, DMOD}; pg8::StaticOrder S; S.init(MT, IN0W, G, bx);
        pg8::EpiBf16Row E{(bf16*)(ws + WS_PROJ), IN0W, (const float*)(ws + WS_R0)};
        pg8::gemm_phase<pg8::EpiBf16Row, pg8::StaticOrder, PG8_ALIGN, PG8_SP2>(lds, g, S, E);
    }
    SEAM(1);
    if (IN(2)) {
        const bool fuse = (G == 256) && (a.mask == -1);
        { int k = 0;
#pragma unroll 1
          for (int u = bx; u < MT / 32; u += G, ++k) { if (a.mask & 1) mixer_a_unit(a, lds, u, tid, lane, wave, fuse ? gw * 8 + k * 4 : -1); } }
        if (!fuse && (a.mask & 2)) qk_prep_phase(a, gw, NGW, lane);
    }
    SEAM(2);
#if defined(TWICE_P) && TWICE_P == 3
    for (int rep3 = 0; rep3 < 2; ++rep3)
#endif
    if (IN(3)) {
        const attn_body::bf16* PROJ = (const attn_body::bf16*)(ws + WS_PROJ); attn_body::bf16* OP = (attn_body::bf16*)(ws + WS_PROJ);
        const int per = (512 + G - 1) / G;
#pragma unroll 1
        for (int ui = 0; ui < 2 * per; ++ui) { const int pi = vcu * per + (ui >> 1); if (pi >= 512) break;
            const int bhc = pi >> 3, s = pi & 7, b = bhc >> 4, h = (bhc >> 1) & 7, c = bhc & 1;
            const attn_body::bf16* Q = PROJ + 3072 + h * 128 + c * 64; const attn_body::bf16* K = PROJ + 4096 + h * 128 + c * 64; const attn_body::bf16* V = PROJ + 5120 + h * 128;
            attn_body::bf16* O = OP + c * 1024 + h * 128;
            attn_body::attn_unit<8>(b, (ui & 1) ? 15 - s : s, Q, K, V, O, (char*)lds_raw);
        }
    }
    SEAM(3);
    if (IN(4)) {
        const float p1 = a.in[9][lane] * a.in[10][lane], p2 = a.in[11][lane] * a.in[12][lane];
        const float lam = expf(wave_sum(p1)) - expf(wave_sum(p2)) + 0.2f;
        combine_phase(a, gw, NGW, lane, lam);
    }
    SEAM(4);
    if (IN(5)) {
        pg8::Gemm g{(const bf16*)(ws + WS_CAT), (const bf16*)(ws + WS_WOUT0), MT, DMOD, DMOD}; pg8::StaticOrder S; S.init(MT, DMOD, G, bx);
        pg8::EpiResNorm E{(bf16*)(ws + WS_H), (float*)(ws + WS_SUMSQ)};
        pg8::gemm_phase<pg8::EpiResNorm, pg8::StaticOrder, PG8_ALIGN, PG8_SP2>(lds, g, S, E);
    }
    SEAM(5);
    if (IN(7)) {
        pg8::Gemm g{(const bf16*)(ws + WS_H), (const bf16*)(ws + WS_WIN1), MT, 4096, DMOD}; pg8::StaticOrder S; S.init(MT, 4096, G, bx);
        pg8::EpiUG E{(bf16*)(ws + WS_UGM), (bf16*)(ws + WS_GATE), MT, (const float*)(ws + WS_SUMSQ)};
        pg8::gemm_phase<pg8::EpiUG, pg8::StaticOrder, PG8_ALIGN, PG8_SP2>(lds, g, S, E);
    }
    if (IN(7) && IN(8)) {
        const int g = bx & 127; const int t7 = wave * 64 + (int)__builtin_amdgcn_mbcnt_hi(~0u, __builtin_amdgcn_mbcnt_lo(~0u, 0u)); unsigned acc = 0u;
        const unsigned* wf = (const unsigned*)(ws + WS_WF) + (size_t)g * 32768; const unsigned* vf = (const unsigned*)(ws + WS_VF) + (size_t)g * 32768; const unsigned* tf = (const unsigned*)(ws + WS_TF) + (size_t)g * 8192;
#pragma unroll
        for (int i = 0; i < 2; ++i) { acc ^= wf[(t7 + i * NTHR) * 32]; acc ^= vf[(t7 + i * NTHR) * 32]; }
        if (t7 < 256) acc ^= tf[t7 * 32];
        asm volatile("" :: "v"(acc));
    }
    SEAM(7);
    if (IN(8)) { s5_phase(a, lds, bx, G, tid, lane, wave); }
#if defined(TWICE_P) && TWICE_P == 8
    s5_phase(a, lds, bx, G, tid, lane, wave);
#endif
    SEAM(8);
    if (IN(9)) {
        pg8::Gemm g{(const bf16*)(ws + WS_Z), (const bf16*)(ws + WS_WGLU), MT, DMOD, DMOD}; pg8::StaticOrder S; S.init(MT, DMOD, G, bx);
        pg8::EpiGlu E{(const bf16*)(ws + WS_Z), (const bf16*)(ws + WS_GATE), (bf16*)(ws + WS_OUT2), a.in[26]};
        pg8::gemm_phase<pg8::EpiGlu, pg8::StaticOrder, PG8_ALIGN, PG8_SP2>(lds, g, S, E);
    }
    SEAM(9);
    if (IN(10)) {
        pg8::Gemm g{(const bf16*)(ws + WS_OUT2), (const bf16*)(ws + WS_WOUT1), MT, DMOD, DMOD}; pg8::StaticOrder S; S.init(MT, DMOD, G, bx);
        pg8::EpiResOut E{(const bf16*)(ws + WS_H), a.out};
        pg8::gemm_phase<pg8::EpiResOut, pg8::StaticOrder, PG8_ALIGN, PG8_SP2>(lds, g, S, E);
    }
#ifdef PROBE_XBAR
    for (int q = 0; q < PROBE_XBAR; ++q) xcd_barrier(bar);
#endif
#ifdef PROBE_A
    STAMP(11);
    xcd_barrier(bar);
    if (bx == 0) { const unsigned long long* ts = (const unsigned long long*)(ws + 32768);
        const float dA = (float)(ts[PROBE_A + 1] - ts[PROBE_A]) * 0.01f, dB = (float)(ts[PROBE_B + 1] - ts[PROBE_B]) * 0.01f;
        if (tid == 0) a.out[0] += dA;
        for (int i = tid; i < 4096; i += NTHR) a.out[4096 + i] += dB * 0.125f; }
#endif
#undef IN
#undef SEAM
}

extern "C" void kernel_launch(void* const* d_in, const int* in_sizes, int n_in, void* d_out, int out_size, void* d_ws, size_t ws_size, hipStream_t stream) {
    static int grid = 0;
    if (grid == 0) {
        if (n_in != 28 || in_sizes[0] != MT * DMOD || out_size != MT * DMOD || ws_size < WS_END) { fprintf(stderr, "kernel_launch: unexpected shapes (n_in %d, in0 %d, out %d, ws %zu)\n", n_in, n_in > 0 ? in_sizes[0] : -1, out_size, ws_size); grid = -1; return; }
        int dev = 0, cus = 0, per_cu = 0;
        if (hipGetDevice(&dev) != hipSuccess || hipDeviceGetAttribute(&cus, hipDeviceAttributeMultiprocessorCount, dev) != hipSuccess) { grid = -1; return; }
        if (hipFuncSetAttribute((const void*)fwd_kernel, hipFuncAttributeMaxDynamicSharedMemorySize, LDS_BYTES) != hipSuccess) { fprintf(stderr, "kernel_launch: hipFuncSetAttribute failed\n"); grid = -1; return; }
        if (hipOccupancyMaxActiveBlocksPerMultiprocessor(&per_cu, (const void*)fwd_kernel, NTHR, LDS_BYTES) != hipSuccess || per_cu < 1) { fprintf(stderr, "kernel_launch: occupancy query says %d blocks per CU\n", per_cu); (void)hipGetLastError(); grid = -1; return; }
        grid = cus;
    }
    if (grid < 0) return;
    if (hipMemsetAsync(d_ws, 0, WS_ZERO_BYTES, stream) != hipSuccess) { fprintf(stderr, "kernel_launch: memset failed\n"); return; }
    Args a{};
    for (int i = 0; i < 28; ++i) a.in[i] = (const float*)d_in[i];
    a.out = (float*)d_out; a.ws = (unsigned char*)d_ws;
    void* args[] = {&a};
    a.mask = -1;
#if defined(PROBE_LO)
    a.ph_lo = PROBE_LO; a.ph_hi = PROBE_HI; a.mask = PROBE_MASK;
    (void)hipLaunchCooperativeKernel((const void*)fwd_kernel, dim3(grid), dim3(NTHR), args, LDS_BYTES, stream);
    (void)hipMemsetAsync(d_ws, 0, WS_ZERO_BYTES, stream);
    a.mask = -1;
#endif
#if defined(PROBE_PREFIX)
    a.ph_lo = 0; a.ph_hi = PROBE_PREFIX;
    (void)hipLaunchCooperativeKernel((const void*)fwd_kernel, dim3(grid), dim3(NTHR), args, LDS_BYTES, stream);
    (void)hipMemsetAsync(d_ws, 0, WS_ZERO_BYTES, stream);
#endif
#if MK_N_LAUNCHES == 1
    a.ph_lo = 0; a.ph_hi = NPH;
    hipError_t e = hipLaunchCooperativeKernel((const void*)fwd_kernel, dim3(grid), dim3(NTHR), args, LDS_BYTES, stream);
    if (e != hipSuccess) fprintf(stderr, "kernel_launch: cooperative launch failed: %s (grid %d)\n", hipGetErrorString(e), grid);
#else
    for (int ph = 0; ph < NPH; ++ph) { a.ph_lo = ph; a.ph_hi = ph + 1;
        hipError_t e = hipLaunchCooperativeKernel((const void*)fwd_kernel, dim3(grid), dim3(NTHR), args, LDS_BYTES, stream);
        if (e != hipSuccess) { fprintf(stderr, "kernel_launch: cooperative launch %d failed: %s (grid %d)\n", ph, hipGetErrorString(e), grid); break; } }
#endif
}
```

```cpp
#include <hip/hip_runtime.h>
#include <hip/hip_cooperative_groups.h>
#include <hip/hip_bf16.h>
#include <cstdio>
#include <cstdint>
#include <cmath>
namespace cg = cooperative_groups;
namespace pg8 {
#define PG8_LAS __attribute__((address_space(3)))
typedef unsigned short bf16_t;
typedef short bf16x8 __attribute__((ext_vector_type(8)));
typedef float f32x4 __attribute__((ext_vector_type(4)));
typedef unsigned u32x4 __attribute__((ext_vector_type(4)));
constexpr int BM = 256, BK = 64, HALF = 128, HTB = HALF * BK * 2  , STAGE_BYTES = 8 * HTB, NXCD = 8, WGM = 8;

__host__ __device__ __forceinline__ int lds_byte(int r, int c) { const int st = (r >> 4) * 2 + (c >> 5), rr = r & 15, cc = c & 31, ob = rr * 64 + cc * 2; return st * 1024 + (ob ^ (((ob >> 9) & 1) << 5)); }
__host__ __device__ __forceinline__ void stage_rc(int b, int& R, int& C) { const int st = b / 1024, sb = b % 1024, swz = sb ^ (((sb >> 9) & 1) << 5); R = (st >> 1) * 16 + swz / 64; C = (st & 1) * 32 + (swz % 64) / 2; }
__host__ __device__ __forceinline__ int perm32(int rho) { const int n = rho >> 4, i = rho & 15; return 8 * (i >> 2) + 4 * n + (i & 3); }

struct Unit { int pm, pn; };
struct Gemm { const bf16_t* A; const bf16_t* Bt; int M, N, K; };

struct StaticOrder {
    int nM, nN, nwg, G, c;
    __host__ __device__ void init(int M, int N, int G_, int c_) { nM = M / BM; nN = N / BM; nwg = nM * nN; G = G_; c = c_; }
    __host__ __device__ bool next(int i, Unit& u) const {
        const long L = (long)i * G + c; if (L >= nwg) return false;
        int wgid = (int)L; { const int q = nwg / NXCD, r = nwg % NXCD, xcd = wgid % NXCD, off = wgid / NXCD; wgid = (xcd < r ? xcd * (q + 1) : r * (q + 1) + (xcd - r) * q) + off; }
        const int nig = WGM * nN, gid = wgid / nig, fm = gid * WGM, gsz = (nM - fm) < WGM ? (nM - fm) : WGM;
        u.pm = fm + ((wgid % nig) % gsz); u.pn = (wgid % nig) / gsz; return true;
    }
    __device__ __forceinline__ void a_ready(const Unit&) const {}
    __device__ __forceinline__ void done(const Unit&) const {}
};

__device__ __forceinline__ unsigned cvt_pk_bf16(float lo, float hi) { unsigned r; asm volatile("v_cvt_pk_bf16_f32 %0, %1, %2" : "=v"(r) : "v"(lo), "v"(hi)); return r; }
typedef float f32x2 __attribute__((ext_vector_type(2)));
__device__ __forceinline__ f32x2 gelu_pk(f32x2 v) {
    const f32x2 av = __builtin_elementwise_abs(v), d = av * 0.2316418882f + 1.0f;
    f32x2 t; t.x = __builtin_amdgcn_rcpf(d.x); t.y = __builtin_amdgcn_rcpf(d.y);
    f32x2 q = t * 0.5307027145f + (-0.7265760135f); q = q * t + 0.7107068705f; q = q * t + (-0.142248368f); q = q * t + 0.127414796f; q = q * t;
    const f32x2 s = (v * v) * (-0.72134752044f);
    f32x2 e; e.x = __builtin_amdgcn_exp2f(s.x); e.y = __builtin_amdgcn_exp2f(s.y);
    const f32x2 m = v * (q * e), r = v - m;
    f32x2 o; o.x = v.x < 0.f ? m.x : r.x; o.y = v.y < 0.f ? m.y : r.y; return o;
}

template <int ACT  > struct EpiBf16 {
    static constexpr bool PERM = true, AFTER_DRAIN = false; static_assert(ACT == 0 || ACT == 1, "EpiBf16: ACT is 0 (none) or 1 (gelu_pk)");
    bf16_t* O; int ldc; const float* bias; int split_cols; size_t split_stride; float scale0;
    __device__ __forceinline__ void operator()(const f32x4 (&acc)[2][2][4][2], const Unit& u, int wr, int wc, int fr, int fq) const {
        const int row0 = u.pm * BM + wr * 64 + fr; int colt = u.pn * BM; bf16_t* base = O;
        float sc = 1.f; if (split_cols) { const int t = colt / split_cols; base += (size_t)t * split_stride; colt -= t * split_cols; if (t == 0) sc = scale0; }
        const int col0 = colt + wc * 32 + 8 * fq, bcol0 = u.pn * BM + wc * 32 + 8 * fq;
        f32x4 bv[2][2];
#pragma unroll
        for (int bj = 0; bj < 2; ++bj)
#pragma unroll
            for (int n = 0; n < 2; ++n) bv[bj][n] = bias ? *(const f32x4*)(bias + bcol0 + bj * HALF + 4 * n) : (f32x4){0.f, 0.f, 0.f, 0.f};
#pragma unroll
        for (int ai = 0; ai < 2; ++ai)
#pragma unroll
            for (int m = 0; m < 4; ++m) { bf16_t* rowp = base + (size_t)(row0 + ai * HALF + m * 16) * ldc + col0;
#pragma unroll
                for (int bj = 0; bj < 2; ++bj) { f32x4 v0 = acc[ai][bj][m][0] + bv[bj][0], v1 = acc[ai][bj][m][1] + bv[bj][1];
                    if (ACT == 1) { f32x2 a = gelu_pk((f32x2){v0[0], v0[1]}), b = gelu_pk((f32x2){v0[2], v0[3]}), c = gelu_pk((f32x2){v1[0], v1[1]}), d = gelu_pk((f32x2){v1[2], v1[3]});
                        v0 = (f32x4){a.x, a.y, b.x, b.y}; v1 = (f32x4){c.x, c.y, d.x, d.y}; }
                    v0 = v0 * sc; v1 = v1 * sc; u32x4 w; w.x = cvt_pk_bf16(v0[0], v0[1]); w.y = cvt_pk_bf16(v0[2], v0[3]); w.z = cvt_pk_bf16(v1[0], v1[1]); w.w = cvt_pk_bf16(v1[2], v1[3]);
                    *(u32x4*)(rowp + bj * HALF) = w; } }
    }
};
__device__ __forceinline__ float bflo(unsigned u) { return __uint_as_float(u << 16); }
__device__ __forceinline__ float bfhi(unsigned u) { return __uint_as_float(u & 0xffff0000u); }
__device__ __forceinline__ float sigm(float x) { return __builtin_amdgcn_rcpf(1.0f + __expf(-x)); }
struct EpiBf16Row {
    static constexpr bool PERM = true, AFTER_DRAIN = false;
    bf16_t* O; int ldc; const float* rs;
    __device__ __forceinline__ void operator()(const f32x4 (&acc)[2][2][4][2], const Unit& u, int wr, int wc, int fr, int fq) const {
        const int row0 = u.pm * BM + wr * 64 + fr, col0 = u.pn * BM + wc * 32 + 8 * fq;
        const bool silu_tile = (u.pn >= 8 && u.pn < 12) || u.pn >= 24;
        if (u.pn < 8) {
#pragma unroll
            for (int ai = 0; ai < 2; ++ai)
#pragma unroll
                for (int m = 0; m < 4; ++m) { const int row = row0 + ai * HALF + m * 16; const float sc = rs[row];
                    const f32x4 v0 = acc[ai][0][m][0] * sc, v1 = acc[ai][0][m][1] * sc, g0 = acc[ai][1][m][0] * sc, g1 = acc[ai][1][m][1] * sc;
                    u32x4 w; w.x = cvt_pk_bf16(v0[0] * sigm(g0[0]), v0[1] * sigm(g0[1])); w.y = cvt_pk_bf16(v0[2] * sigm(g0[2]), v0[3] * sigm(g0[3]));
                    w.z = cvt_pk_bf16(v1[0] * sigm(g1[0]), v1[1] * sigm(g1[1])); w.w = cvt_pk_bf16(v1[2] * sigm(g1[2]), v1[3] * sigm(g1[3]));
                    *(u32x4*)(O + (size_t)row * ldc + u.pn * 128 + wc * 32 + 8 * fq) = w; }
            return; }
#pragma unroll
        for (int ai = 0; ai < 2; ++ai)
#pragma unroll
            for (int m = 0; m < 4; ++m) { const int row = row0 + ai * HALF + m * 16; const float sc = rs[row]; bf16_t* rowp = O + (size_t)row * ldc + col0;
#pragma unroll
                for (int bj = 0; bj < 2; ++bj) { f32x4 v0 = acc[ai][bj][m][0] * sc, v1 = acc[ai][bj][m][1] * sc;
                    if (silu_tile) {
#pragma unroll
                        for (int e = 0; e < 4; ++e) { v0[e] *= sigm(v0[e]); v1[e] *= sigm(v1[e]); } }
                    u32x4 w; w.x = cvt_pk_bf16(v0[0], v0[1]); w.y = cvt_pk_bf16(v0[2], v0[3]); w.z = cvt_pk_bf16(v1[0], v1[1]); w.w = cvt_pk_bf16(v1[2], v1[3]);
                    *(u32x4*)(rowp + bj * HALF) = w; } }
    }
};
struct EpiResF32 {
    static constexpr bool PERM = false, AFTER_DRAIN = false;
    const float* base; float* out; int ldc;
    __device__ __forceinline__ void operator()(const f32x4 (&acc)[2][2][4][2], const Unit& u, int wr, int wc, int fr, int fq) const {
        const int row0 = u.pm * BM + wr * 64 + fr, col0 = u.pn * BM + wc * 32 + 4 * fq;
#pragma unroll
        for (int ai = 0; ai < 2; ++ai)
#pragma unroll
            for (int m = 0; m < 4; ++m) { const size_t off = (size_t)(row0 + ai * HALF + m * 16) * ldc + col0;
#pragma unroll
                for (int bj = 0; bj < 2; ++bj)
#pragma unroll
                    for (int n = 0; n < 2; ++n) { const f32x4 b = *(const f32x4*)(base + off + bj * HALF + n * 16); *(f32x4*)(out + off + bj * HALF + n * 16) = b + acc[ai][bj][m][n]; } }
    }
};
struct EpiResNorm {
    static constexpr bool PERM = true, AFTER_DRAIN = false;
    bf16_t* X; float* sumsq;
    __device__ __forceinline__ void operator()(const f32x4 (&acc)[2][2][4][2], const Unit& u, int wr, int wc, int fr, int fq) const {
        const int row0 = u.pm * BM + wr * 64 + fr, colb = u.pn * BM + wc * 32 + 8 * fq;
#pragma unroll
        for (int ai = 0; ai < 2; ++ai) {
            u32x4 xb[4][2];
#pragma unroll
            for (int m = 0; m < 4; ++m)
#pragma unroll
                for (int bj = 0; bj < 2; ++bj) xb[m][bj] = *(const u32x4*)(X + (size_t)(row0 + ai * HALF + m * 16) * 2048 + colb + bj * HALF);
#pragma unroll
            for (int m = 0; m < 4; ++m) { const int row = row0 + ai * HALF + m * 16; const size_t off = (size_t)row * 2048 + colb; float ss = 0.f;
#pragma unroll
                for (int bj = 0; bj < 2; ++bj) { const u32x4 xv = xb[m][bj];
                    const f32x4 x0 = (f32x4){bflo(xv.x), bfhi(xv.x), bflo(xv.y), bfhi(xv.y)} + acc[ai][bj][m][0], x1 = (f32x4){bflo(xv.z), bfhi(xv.z), bflo(xv.w), bfhi(xv.w)} + acc[ai][bj][m][1];
                    ss += (x0[0] * x0[0] + x0[1] * x0[1]) + (x0[2] * x0[2] + x0[3] * x0[3]) + (x1[0] * x1[0] + x1[1] * x1[1]) + (x1[2] * x1[2] + x1[3] * x1[3]);
                    u32x4 w; w.x = cvt_pk_bf16(x0[0], x0[1]); w.y = cvt_pk_bf16(x0[2], x0[3]); w.z = cvt_pk_bf16(x1[0], x1[1]); w.w = cvt_pk_bf16(x1[2], x1[3]);
                    *(u32x4*)(X + off + bj * HALF) = w; }
                ss += __shfl_xor(ss, 16); ss += __shfl_xor(ss, 32);
                if (fq == 0) (void)__hip_atomic_fetch_add(sumsq + row, ss, __ATOMIC_RELAXED, __HIP_MEMORY_SCOPE_AGENT); } }
    }
};
struct EpiResOut {
    static constexpr bool PERM = true, AFTER_DRAIN = false;
    const bf16_t* base; float* out;
    __device__ __forceinline__ void operator()(const f32x4 (&acc)[2][2][4][2], const Unit& u, int wr, int wc, int fr, int fq) const {
        const int row0 = u.pm * BM + wr * 64 + fr, colb = u.pn * BM + wc * 32 + 8 * fq;
#pragma unroll
        for (int ai = 0; ai < 2; ++ai) {
            u32x4 xb[4][2];
#pragma unroll
            for (int m = 0; m < 4; ++m)
#pragma unroll
                for (int bj = 0; bj < 2; ++bj) xb[m][bj] = *(const u32x4*)(base + (size_t)(row0 + ai * HALF + m * 16) * 2048 + colb + bj * HALF);
#pragma unroll
            for (int m = 0; m < 4; ++m) { const size_t off = (size_t)(row0 + ai * HALF + m * 16) * 2048 + colb;
#pragma unroll
                for (int bj = 0; bj < 2; ++bj) { const u32x4 xv = xb[m][bj];
                    *(f32x4*)(out + off + bj * HALF) = (f32x4){bflo(xv.x), bfhi(xv.x), bflo(xv.y), bfhi(xv.y)} + acc[ai][bj][m][0];
                    *(f32x4*)(out + off + bj * HALF + 4) = (f32x4){bflo(xv.z), bfhi(xv.z), bflo(xv.w), bfhi(xv.w)} + acc[ai][bj][m][1]; } } }
    }
};
struct EpiUG {
    static constexpr bool PERM = true, AFTER_DRAIN = false;
    bf16_t* Ugm; bf16_t* Gate; int mrows; const float* sumsq;
    __device__ __forceinline__ void operator()(const f32x4 (&acc)[2][2][4][2], const Unit& u, int wr, int wc, int fr, int fq) const {
        const int row0 = u.pm * BM + wr * 64 + fr, colb = u.pn * BM + wc * 32 + 8 * fq;
#pragma unroll
        for (int ai = 0; ai < 2; ++ai)
#pragma unroll
            for (int m = 0; m < 4; ++m) { const int row = row0 + ai * HALF + m * 16; const float rs = 1.0f / sqrtf(sumsq[row] * (1.0f / 2048.0f) + 1e-6f);
#pragma unroll
                for (int bj = 0; bj < 2; ++bj) { const int col = colb + bj * HALF; const f32x4 v0 = acc[ai][bj][m][0] * rs, v1 = acc[ai][bj][m][1] * rs;
                    u32x4 w; w.x = cvt_pk_bf16(v0[0], v0[1]); w.y = cvt_pk_bf16(v0[2], v0[3]); w.z = cvt_pk_bf16(v1[0], v1[1]); w.w = cvt_pk_bf16(v1[2], v1[3]);
                    if (col < 2048) *(u32x4*)(Ugm + ((size_t)(col >> 4) * mrows + row) * 16 + (col & 8)) = w;
                    else *(u32x4*)(Gate + (size_t)row * 2048 + (col - 2048)) = w; } }
    }
};
struct EpiGlu {
    static constexpr bool PERM = true, AFTER_DRAIN = false;
    const bf16_t* Z; const bf16_t* Gate; bf16_t* O; const float* bias;
    __device__ __forceinline__ void operator()(const f32x4 (&acc)[2][2][4][2], const Unit& u, int wr, int wc, int fr, int fq) const {
        const int row0 = u.pm * BM + wr * 64 + fr, colb = u.pn * BM + wc * 32 + 8 * fq;
        f32x4 bv[2][2];
#pragma unroll
        for (int bj = 0; bj < 2; ++bj)
#pragma unroll
            for (int n = 0; n < 2; ++n) bv[bj][n] = *(const f32x4*)(bias + colb + bj * HALF + 4 * n);
#pragma unroll
        for (int ai = 0; ai < 2; ++ai)
#pragma unroll
            for (int m = 0; m < 4; ++m) { const size_t roff = (size_t)(row0 + ai * HALF + m * 16) * 2048 + colb;
#pragma unroll
                for (int bj = 0; bj < 2; ++bj) { const f32x4 v0 = acc[ai][bj][m][0] + bv[bj][0], v1 = acc[ai][bj][m][1] + bv[bj][1];
                    const u32x4 zz = *(const u32x4*)(Z + roff + bj * HALF), gg = *(const u32x4*)(Gate + roff + bj * HALF);
                    float o[8]; const float a[8] = {v0[0], v0[1], v0[2], v0[3], v1[0], v1[1], v1[2], v1[3]};
#pragma unroll
                    for (int q = 0; q < 4; ++q) { const unsigned zw = zz[q], gw = gg[q]; const float z0 = bflo(zw), z1 = bfhi(zw), g0 = bflo(gw), g1 = bfhi(gw);
                        o[2 * q] = z0 * sigm(a[2 * q]) * (g0 * sigm(g0)); o[2 * q + 1] = z1 * sigm(a[2 * q + 1]) * (g1 * sigm(g1)); }
                    u32x4 w; w.x = cvt_pk_bf16(o[0], o[1]); w.y = cvt_pk_bf16(o[2], o[3]); w.z = cvt_pk_bf16(o[4], o[5]); w.w = cvt_pk_bf16(o[6], o[7]);
                    *(u32x4*)(O + roff + bj * HALF) = w; } }
    }
};

template <class Epi, class Sched, bool ALIGN_EPI = false, bool SP2 = false>
__device__ __forceinline__ void gemm_phase(PG8_LAS unsigned char* lds, const Gemm g, const Sched& S, const Epi& E) {
    const int tid = threadIdx.x, wid = __builtin_amdgcn_readfirstlane(tid >> 6), lane = tid & 63, wr = wid >> 2, wc = wid & 3, fr = lane & 15, fq = lane >> 4;
    const int K = g.K, nt = K / BK;
    unsigned voffA[2], voffB[2];
#pragma unroll
    for (int i = 0; i < 2; ++i) { int R, C; stage_rc(tid * 16 + i * 8192, R, C); const int Rb = Epi::PERM ? ((R & ~31) + perm32(R & 31)) : R;
        voffA[i] = (unsigned)(R * K + C) * 2u; voffB[i] = (unsigned)(Rb * K + C) * 2u; }
    const size_t kstep = (size_t)(BK * 2);
    const size_t hstep = (size_t)HALF * K * 2;
    const size_t tstep = 2 * hstep;
    const unsigned ldsw = (unsigned)wid * 1024u;
    const int aoff = lds_byte(wr * 64 + fr, fq * 8), boff = lds_byte(wc * 32 + fr, fq * 8);
#define PG8_SA(b, h) (((b) * 2 + (h)) * HTB)
#define PG8_SB(b, h) ((4 + (b) * 2 + (h)) * HTB)
#define PG8_STAGE(bufoff, gbase, voff) do { _Pragma("unroll") for (int _i = 0; _i < 2; ++_i) \
        __builtin_amdgcn_global_load_lds((const unsigned*)((const char*)(gbase) + (voff)[_i]), (PG8_LAS unsigned*)(lds + (bufoff) + ldsw + _i * 8192), 16, 0, 0); } while (0)
#define PG8_LDA(dst, b, h) do { _Pragma("unroll") for (int m = 0; m < 4; ++m) _Pragma("unroll") for (int k = 0; k < 2; ++k) dst[m][k] = *(const PG8_LAS bf16x8*)(lds + PG8_SA(b, h) + aoff + m * 2048 + k * 1024); } while (0)
#define PG8_LDB(dst, b, h) do { _Pragma("unroll") for (int n = 0; n < 2; ++n) _Pragma("unroll") for (int k = 0; k < 2; ++k) dst[n][k] = *(const PG8_LAS bf16x8*)(lds + PG8_SB(b, h) + boff + n * 2048 + k * 1024); } while (0)
#define PG8_MMA(ai, bj, At, Bt) do { __builtin_amdgcn_s_setprio(1); _Pragma("unroll") for (int m = 0; m < 4; ++m) _Pragma("unroll") for (int n = 0; n < 2; ++n) _Pragma("unroll") for (int k = 0; k < 2; ++k) \
        acc[ai][bj][m][n] = __builtin_amdgcn_mfma_f32_16x16x32_bf16(Bt[n][k], At[m][k], acc[ai][bj][m][n], 0, 0, 0); __builtin_amdgcn_s_setprio(0); } while (0)
#define PG8_WAIT_V(n) asm volatile("s_waitcnt vmcnt(" #n ")" ::: "memory")
#define PG8_WAIT_L(n) asm volatile("s_waitcnt lgkmcnt(" #n ")" ::: "memory")
#define PG8_BAR __builtin_amdgcn_s_barrier()
#define PG8_SCHED __builtin_amdgcn_sched_barrier(0)
    Unit cur, nxt; int ui = 0;
    if (!S.next(0, cur)) return;
    f32x4 acc[2][2][4][2];
#pragma unroll
    for (int a = 0; a < 2; ++a)
#pragma unroll
        for (int b = 0; b < 2; ++b)
#pragma unroll
            for (int m = 0; m < 4; ++m)
#pragma unroll
                for (int n = 0; n < 2; ++n) acc[a][b][m][n] = (f32x4){0.f, 0.f, 0.f, 0.f};
    bf16x8 At[4][2], B0[2][2], B1[2][2];
    const char* cA = (const char*)g.A + (size_t)cur.pm * tstep; const char* cB = (const char*)g.Bt + (size_t)cur.pn * tstep;
    S.a_ready(cur);
    if constexpr (SP2) {
        PG8_STAGE(PG8_SB(0, 0), cB, voffB); PG8_STAGE(PG8_SB(0, 1), cB + hstep, voffB); PG8_STAGE(PG8_SA(0, 0), cA, voffA); PG8_STAGE(PG8_SA(0, 1), cA + hstep, voffA);
        if (wr == 1) PG8_BAR;
        PG8_WAIT_V(2); PG8_BAR;
        PG8_STAGE(PG8_SB(1, 0), cB + kstep, voffB); PG8_STAGE(PG8_SA(1, 0), cA + kstep, voffA); PG8_STAGE(PG8_SB(1, 1), cB + hstep + kstep, voffB);
        PG8_WAIT_V(6); PG8_BAR;
    } else {
        PG8_STAGE(PG8_SB(0, 0), cB, voffB); PG8_STAGE(PG8_SA(0, 0), cA, voffA); PG8_STAGE(PG8_SB(0, 1), cB + hstep, voffB); PG8_STAGE(PG8_SA(0, 1), cA + hstep, voffA);
        if (wr == 1) PG8_BAR;
        PG8_WAIT_V(4); PG8_BAR;
        PG8_STAGE(PG8_SB(1, 0), cB + kstep, voffB); PG8_STAGE(PG8_SA(1, 0), cA + kstep, voffA); PG8_STAGE(PG8_SB(1, 1), cB + hstep + kstep, voffB);
        PG8_WAIT_V(6); PG8_BAR;
    }
    for (;;) {
        const bool has_next = S.next(ui + 1, nxt);
        const char* nA = has_next ? (const char*)g.A + (size_t)nxt.pm * tstep : cA; const char* nB = has_next ? (const char*)g.Bt + (size_t)nxt.pn * tstep : cB;
        for (int t = 0; t < nt; t += 2) {
            const bool last = (t == nt - 2);
            const char* a1 = cA + (size_t)(t + 1) * kstep;
            const char* a2 = last ? nA : cA + (size_t)(t + 2) * kstep; const char* b2 = last ? nB : cB + (size_t)(t + 2) * kstep;
            const char* a3 = a2 + kstep; const char* b3 = b2 + kstep;
            if (last && has_next) S.a_ready(nxt);
            if constexpr (SP2) {
            PG8_LDB(B0, 0, 0); PG8_LDB(B1, 0, 1); PG8_SCHED; PG8_LDA(At, 0, 0); PG8_STAGE(PG8_SA(1, 1), a1 + hstep, voffA);
            PG8_WAIT_V(8); PG8_WAIT_L(0); PG8_BAR; PG8_MMA(0, 0, At, B0); PG8_MMA(0, 1, At, B1); PG8_BAR; PG8_SCHED;
            PG8_LDA(At, 0, 1); PG8_STAGE(PG8_SB(0, 0), b2, voffB); PG8_STAGE(PG8_SB(0, 1), b2 + hstep, voffB); PG8_STAGE(PG8_SA(0, 0), a2, voffA);
            PG8_WAIT_V(8); PG8_WAIT_L(0); PG8_BAR; PG8_MMA(1, 0, At, B0); PG8_MMA(1, 1, At, B1); PG8_BAR; PG8_SCHED;
            PG8_LDB(B0, 1, 0); PG8_LDB(B1, 1, 1); PG8_SCHED; PG8_LDA(At, 1, 0); PG8_STAGE(PG8_SA(0, 1), a2 + hstep, voffA);
            PG8_WAIT_V(8); PG8_WAIT_L(0); PG8_BAR; PG8_MMA(0, 0, At, B0); PG8_MMA(0, 1, At, B1); PG8_BAR; PG8_SCHED;
            PG8_LDA(At, 1, 1); PG8_STAGE(PG8_SB(1, 0), b3, voffB); PG8_STAGE(PG8_SB(1, 1), b3 + hstep, voffB); PG8_STAGE(PG8_SA(1, 0), a3, voffA);
            PG8_WAIT_V(8); PG8_WAIT_L(0); PG8_BAR; PG8_MMA(1, 0, At, B0); PG8_MMA(1, 1, At, B1); PG8_BAR; PG8_SCHED;
            } else {
            PG8_LDB(B0, 0, 0); PG8_SCHED; PG8_LDA(At, 0, 0); PG8_STAGE(PG8_SA(1, 1), a1 + hstep, voffA);
            PG8_WAIT_L(8); PG8_BAR; PG8_WAIT_L(0); PG8_MMA(0, 0, At, B0); PG8_BAR; PG8_SCHED;
            PG8_LDB(B1, 0, 1); PG8_STAGE(PG8_SB(0, 0), b2, voffB);
            PG8_BAR; PG8_WAIT_L(0); PG8_MMA(0, 1, At, B1); PG8_BAR;
            PG8_LDA(At, 0, 1); PG8_STAGE(PG8_SA(0, 0), a2, voffA);
            PG8_BAR; PG8_WAIT_L(0); PG8_MMA(1, 0, At, B0); PG8_BAR; PG8_SCHED;
            PG8_STAGE(PG8_SB(0, 1), b2 + hstep, voffB);
            PG8_WAIT_V(6); PG8_BAR; PG8_MMA(1, 1, At, B1); PG8_BAR;
            PG8_LDB(B0, 1, 0); PG8_SCHED; PG8_LDA(At, 1, 0); PG8_STAGE(PG8_SA(0, 1), a2 + hstep, voffA);
            PG8_WAIT_L(8); PG8_BAR; PG8_WAIT_L(0); PG8_MMA(0, 0, At, B0); PG8_BAR; PG8_SCHED;
            PG8_LDB(B1, 1, 1); PG8_STAGE(PG8_SB(1, 0), b3, voffB);
            PG8_BAR; PG8_WAIT_L(0); PG8_MMA(0, 1, At, B1); PG8_BAR;
            PG8_LDA(At, 1, 1); PG8_STAGE(PG8_SA(1, 0), a3, voffA);
            PG8_BAR; PG8_WAIT_L(0); PG8_MMA(1, 0, At, B0); PG8_BAR; PG8_SCHED;
            PG8_STAGE(PG8_SB(1, 1), b3 + hstep, voffB);
            PG8_WAIT_V(6); PG8_BAR; PG8_MMA(1, 1, At, B1); PG8_BAR;
            }
        }
        if constexpr (ALIGN_EPI) { if (wr == 0) PG8_BAR; }
        if constexpr (!Epi::AFTER_DRAIN) { E(acc, cur, wr, wc, fr, fq); S.done(cur); }
        if (!has_next) break;
#pragma unroll
        for (int a = 0; a < 2; ++a)
#pragma unroll
            for (int b = 0; b < 2; ++b)
#pragma unroll
                for (int m = 0; m < 4; ++m)
#pragma unroll
                    for (int n = 0; n < 2; ++n) acc[a][b][m][n] = (f32x4){0.f, 0.f, 0.f, 0.f};
        cur = nxt; cA = nA; cB = nB; ++ui;
        if constexpr (ALIGN_EPI) { if (wr == 1) PG8_BAR; }
    }
    PG8_WAIT_V(0);
    if constexpr (!ALIGN_EPI) { if (wr == 0) PG8_BAR; }
    PG8_BAR;
    if constexpr (Epi::AFTER_DRAIN) { E.fused(acc, cur, wr, wc, fr, fq, lds, wid, lane); S.done(cur); }
#undef PG8_SA
#undef PG8_SB
#undef PG8_STAGE
#undef PG8_LDA
#undef PG8_LDB
#undef PG8_MMA
#undef PG8_WAIT_V
#undef PG8_WAIT_L
#undef PG8_BAR
#undef PG8_SCHED
}
}

#ifndef PG8_SP2
#define PG8_SP2 true
#endif
#ifndef PG8_ALIGN
#define PG8_ALIGN true
#endif
namespace attn_body {
using bf16=__hip_bfloat16;
using bf16x8=__attribute__((ext_vector_type(8)))short;
using s16x4=__attribute__((ext_vector_type(4)))short;
using f32x16=__attribute__((ext_vector_type(16)))float;
using u32x4=__attribute__((ext_vector_type(4)))unsigned;
constexpr int SEQ=4096,D=64,DM=7168,OPITCH=7168;
constexpr int NW=8,QBLK=32,QB=QBLK*NW,KVBLK=64,NQB=SEQ/QB;
constexpr int ATTN_PITCH=DM, ATTN_UNIT_ROWS=QB;
__device__ __forceinline__ int crow(int r,int hi){return (r&3)+8*(r>>2)+4*hi;}
#define SBAR() __builtin_amdgcn_sched_barrier(0)
__device__ __forceinline__ void cmask(f32x16&p0,f32x16&p1,int jb,int qrel,int hi){
  const float NEG=-INFINITY; int kb=64*jb+4*hi;
  #pragma unroll
  for(int r=0;r<16;++r){int kv=kb+(r&3)+8*(r>>2); if(kv>qrel)p0[r]=NEG; if(kv+32>qrel)p1[r]=NEG;}
}

constexpr int NSLOT=3, SLOTB=8192;
constexpr int VSLOTB=2*SLOTB;
constexpr int LDS_K=0, LDS_V=NSLOT*SLOTB, LDS_WS=LDS_V+NSLOT*VSLOTB, LDS_OST=LDS_WS+NW*64*4, LDS_BYTES=LDS_OST+NW*8192;
constexpr float C2=0.125f*1.4426950408889634f;
__device__ __forceinline__ void glds16(const void*gsrc,unsigned lds_dst){unsigned keep;
  asm volatile("s_mov_b32 %0, m0\n\ts_mov_b32 m0, %2\n\ts_nop 0\n\tglobal_load_lds_dwordx4 %1, off\n\ts_mov_b32 m0, %0":"=&s"(keep):"v"(gsrc),"s"(lds_dst):"memory");}
__device__ __forceinline__ float max3f(float a,float b,float c){float r;asm("v_max3_f32 %0, %1, %2, %3":"=v"(r):"v"(a),"v"(b),"v"(c));return r;}
__device__ __forceinline__ float max2f(float a,float b){float r;asm("v_max_f32_e32 %0, %1, %2":"=v"(r):"v"(a),"v"(b));return r;}
__device__ __forceinline__ float fadd_s(float a,float b){float r;asm("v_add_f32_e32 %0, %1, %2":"=v"(r):"v"(a),"v"(b));return r;}
__device__ __forceinline__ float fsub_s(float a,float b){float r;asm("v_sub_f32_e32 %0, %1, %2":"=v"(r):"v"(a),"v"(b));return r;}
typedef float f32x2_t __attribute__((ext_vector_type(2))); typedef __bf16 bf16x2_t __attribute__((ext_vector_type(2)));
__device__ __forceinline__ unsigned cvtpk_s(float lo,float hi){f32x2_t v={lo,hi};bf16x2_t b=__builtin_convertvector(v,bf16x2_t);return __builtin_bit_cast(unsigned,b);}
#define WAIT_BAR(N) asm volatile("s_waitcnt vmcnt(" #N ") lgkmcnt(0)\n\ts_barrier":::"memory")

__device__ __forceinline__ void qkt(f32x16&p0,f32x16&p1,const char*Kslot,const bf16x8*qr,int r32,int hi){
  const char*kb=Kslot+hi*1024+r32*16;
  #pragma unroll
  for(int d0=0;d0<4;++d0){
    const bf16x8 b0=*reinterpret_cast<const bf16x8*>(kb+d0*2048);
    const bf16x8 b1=*reinterpret_cast<const bf16x8*>(kb+d0*2048+512);
    if(d0==0){p0=__builtin_amdgcn_mfma_f32_32x32x16_bf16(b0,qr[0],f32x16{},0,0,0);p1=__builtin_amdgcn_mfma_f32_32x32x16_bf16(b1,qr[0],f32x16{},0,0,0);}
    else{p0=__builtin_amdgcn_mfma_f32_32x32x16_bf16(b0,qr[d0],p0,0,0,0);p1=__builtin_amdgcn_mfma_f32_32x32x16_bf16(b1,qr[d0],p1,0,0,0);}}
}
typedef __attribute__((address_space(3))) const char* lds_cptr;
typedef short v4i16_t __attribute__((ext_vector_type(4)));
__device__ __forceinline__ void kload8(bf16x8*kf,lds_cptr kp){
  kf[0]=*(const __attribute__((address_space(3))) bf16x8*)(kp);      kf[1]=*(const __attribute__((address_space(3))) bf16x8*)(kp+512);
  kf[2]=*(const __attribute__((address_space(3))) bf16x8*)(kp+2048); kf[3]=*(const __attribute__((address_space(3))) bf16x8*)(kp+2560);
  kf[4]=*(const __attribute__((address_space(3))) bf16x8*)(kp+4096); kf[5]=*(const __attribute__((address_space(3))) bf16x8*)(kp+4608);
  kf[6]=*(const __attribute__((address_space(3))) bf16x8*)(kp+6144); kf[7]=*(const __attribute__((address_space(3))) bf16x8*)(kp+6656);
}
__device__ __forceinline__ void kload2(bf16x8*kf,lds_cptr kp,int j){ kf[2*j]=*(const __attribute__((address_space(3))) bf16x8*)(kp+j*2048); kf[2*j+1]=*(const __attribute__((address_space(3))) bf16x8*)(kp+j*2048+512); }
__device__ __forceinline__ s16x4 vtr(lds_cptr p){ return __builtin_bit_cast(s16x4,__builtin_amdgcn_ds_read_tr16_b64_v4i16((__attribute__((address_space(3))) v4i16_t*)p)); }
__device__ __forceinline__ float rowmax(const f32x16&p0,const f32x16&p1){
  float a=max3f(p0[0],p0[1],p1[0]),b=max3f(p0[2],p0[3],p1[1]);a=max3f(a,p1[2],p1[3]);
  #pragma unroll
  for(int r=4;r<16;r+=4){a=max3f(a,p0[r],p0[r+1]);b=max3f(b,p0[r+2],p0[r+3]);a=max3f(a,p1[r],p1[r+1]);b=max3f(b,p1[r+2],p1[r+3]);}
  const float m=max2f(a,b);
  auto rr=__builtin_amdgcn_permlane32_swap(__float_as_uint(m),__float_as_uint(m),false,false);
  return max2f(__uint_as_float(rr[0]),__uint_as_float(rr[1]));
}
__device__ __forceinline__ void pv(f32x16*o,int vb,bf16x8 pa0,bf16x8 pa1,bf16x8 pa2,bf16x8 pa3){
  #pragma unroll
  for(int d0=0;d0<4;++d0){s16x4 lo[4],hi[4];
    #pragma unroll
    for(int ks=0;ks<4;++ks){
      asm volatile("ds_read_b64_tr_b16 %0,%1 offset:%c2":"=&v"(lo[ks]):"v"(vb),"i"(d0*4096+ks*1024):"memory");
      asm volatile("ds_read_b64_tr_b16 %0,%1 offset:%c2":"=&v"(hi[ks]):"v"(vb),"i"(d0*4096+ks*1024+512):"memory");}
    asm volatile("s_waitcnt lgkmcnt(0)":::"memory");SBAR();
    #define PK(k) (bf16x8){lo[k][0],lo[k][1],lo[k][2],lo[k][3],hi[k][0],hi[k][1],hi[k][2],hi[k][3]}
    o[d0]=__builtin_amdgcn_mfma_f32_32x32x16_bf16(pa0,PK(0),o[d0],0,0,0);
    o[d0]=__builtin_amdgcn_mfma_f32_32x32x16_bf16(pa1,PK(1),o[d0],0,0,0);
    o[d0]=__builtin_amdgcn_mfma_f32_32x32x16_bf16(pa2,PK(2),o[d0],0,0,0);
    o[d0]=__builtin_amdgcn_mfma_f32_32x32x16_bf16(pa3,PK(3),o[d0],0,0,0);
    #undef PK
  }
}

#ifndef ATTN_STORE16
#define ATTN_STORE16(p,v) (*(u32x4*)(p)=(v))
#endif
template<int THRL> __device__ __forceinline__ void attn_unit(int b,int qb,const bf16*Q,const bf16*K,const bf16*V,bf16*O,char*shm){
  const int tid=threadIdx.x,lane=tid&63,r32=lane&31,hi=lane>>5; const int wid=__builtin_amdgcn_readfirstlane(tid>>6);
  const long rowbase=(long)b*SEQ; const int q0=qb*QB;
  const bf16*Qw=Q+(rowbase+q0+wid*QBLK)*DM;
  const bf16*Kh=K+rowbase*DM,*Vh=V+rowbase*DM;
  const unsigned lds0=(unsigned)(uintptr_t)shm;
  float*wsf=(float*)(shm+LDS_WS)+wid*64;
  const bf16*ksrc=Kh+(long)lane*DM+wid*8;
  const bf16*vsrc=Vh+(long)(16*(wid&3)+(lane>>2))*DM+(wid>>2)*32+(lane&3)*8;
  const unsigned kdst=lds0+LDS_K+wid*1024, vdst=lds0+LDS_V+wid*1024;
  #define DMA_K(t,slot) glds16(ksrc+(long)(t)*KVBLK*DM,(unsigned)__builtin_amdgcn_readfirstlane(kdst+(slot)))
  #define DMA_V(t,slot) do{ glds16(vsrc+(long)(t)*KVBLK*DM,(unsigned)__builtin_amdgcn_readfirstlane(vdst+2*(slot))); glds16(vsrc+64+(long)(t)*KVBLK*DM,(unsigned)__builtin_amdgcn_readfirstlane(vdst+8192+2*(slot))); }while(0)
  const int vb0=(int)(lds0+LDS_V)+((lane>>4)&1)*32+(lane&3)*8+(4*hi+((lane&15)>>2))*64;
  const char*Kbase=shm+LDS_K; bf16x8 kf[8];
  const lds_cptr shm3=(lds_cptr)shm; const lds_cptr kp0=shm3+LDS_K+hi*1024+r32*16; const lds_cptr vp0=shm3+LDS_V+((lane>>4)&1)*32+(lane&3)*8+(4*hi+((lane&15)>>2))*64;
  const int NT=(q0+QB)/KVBLK;
  DMA_K(0,0);DMA_V(0,0);DMA_K(1,SLOTB);
  bf16x8 qr[4];
  #pragma unroll
  for(int d0=0;d0<4;++d0)qr[d0]=*reinterpret_cast<const bf16x8*>(&Qw[(long)r32*DM+d0*16+hi*8]);
  float mhat=0.f,l_reg=0.f;f32x16 o[4];o[0]=f32x16{};o[1]=f32x16{};o[2]=f32x16{};o[3]=f32x16{};
  const int qrel=wid*QBLK+r32;
  #define CMASK(P0,P1,t) do{int jb_=(t)-(NT-4); if(jb_>=0)cmask(P0,P1,jb_,qrel,hi);}while(0)
  bool resc=false;
  #define START(P0,P1) do{ const float rm=rowmax(P0,P1); resc=false; \
    { const float dl=rm; mhat=fadd_s(mhat,dl); \
      _Pragma("unroll") for(int r=0;r<16;++r){P0[r]=fsub_s(P0[r],dl);P1[r]=fsub_s(P1[r],dl);} \
      } \
    _Pragma("unroll") for(int r=0;r<16;++r)P0[r]=__builtin_amdgcn_exp2f(P0[r]); }while(0)
  #define RESC() do{ if(resc){ asm volatile("s_waitcnt lgkmcnt(0)":::"memory"); \
      _Pragma("unroll") for(int d_=0;d_<4;++d_) _Pragma("unroll") for(int r=0;r<16;++r)o[d_][r]*=wsf[crow(r,hi)]; } }while(0)
  f32x16 pA0,pA1,pB0,pB1;
  int sl_prev=0,sl_cur=0,sl_next=SLOTB;
  #define ROT() do{sl_prev=sl_cur;sl_cur=sl_next;sl_next=(sl_next==(NSLOT-1)*SLOTB)?0:sl_next+SLOTB;}while(0)
  DMA_K(2,2*SLOTB);
  WAIT_BAR(3);
  qkt(pA0,pA1,Kbase,qr,r32,hi);asm volatile("s_nop 15\n\ts_nop 7":"+v"(pA0),"+v"(pA1));CMASK(pA0,pA1,0);
  START(pA0,pA1);
  _Pragma("unroll") for(int r=0;r<16;++r)pA1[r]=__builtin_amdgcn_exp2f(pA1[r]);
  WAIT_BAR(0);
  DMA_K(3,0);DMA_V(1,SLOTB);
  ROT();
  kload8(kf,kp0+sl_cur);
  WAIT_BAR(3);
  s16x4 vlo[4],vhi[4]; u32x4 pw0,pw1,pw2,pw3;
  #define PKW(P,B) cvtpk_s(P[B],P[B+1])
  #define PAF(k) __builtin_bit_cast(bf16x8,pw##k)
  #define VFRW(s) (bf16x8){vlo[s][0],vlo[s][1],vlo[s][2],vlo[s][3],vhi[s][0],vhi[s][1],vhi[s][2],vhi[s][3]}
  #define PIN(x) asm volatile("":"+v"(x))
  #define MX3(a,b,c) __builtin_fmaxf(__builtin_fmaxf((a),(b)),(c))
  #define GAPA(MF,A0,A1,A2,A3,W0,W1,PW) do{ MF; sacc+=A0; sacc+=A1; sacc+=A2; sacc+=A3; PIN(sacc); W0; W1; PIN(PW); SBAR(); }while(0)
  #define EX(v) __builtin_amdgcn_exp2f(v)
  #define GAPB(MF,X,B) do{ MF; X[B]=EX(X[B]); X[B+1]=EX(X[B+1]); PIN(X); SBAR(); }while(0)
  #define VOFF(f) ((2*((f)>>3)+((f)&1))*4096+(((f)&7)>>1)*1024)
  #define VRDW(f) do{ vlo[(f)&3]=vtr(vp_+VOFF(f)); vhi[(f)&3]=vtr(vp_+VOFF(f)+512); }while(0)
  #define KRD(G,j) do{ if(G){ kload2(kf,kp0+sl_next,j); SBAR(); } }while(0)
  #define STEP(C0,C1,P0,P1,t,GK,GV,GL) do{ SBAR(); \
    const lds_cptr vp_=vp0+2*sl_prev; \
    VRDW(0); SBAR(); float sacc=(P0[0]+P0[1]); \
    GAPA(C0=__builtin_amdgcn_mfma_f32_32x32x16_bf16(kf[0],qr[0],f32x16{},0,0,0), P0[2],P0[3],P0[4],P0[5],     pw0[0]=PKW(P0,0), pw0[1]=PKW(P0,2), pw0); \
    VRDW(1); SBAR(); GAPA(C1=__builtin_amdgcn_mfma_f32_32x32x16_bf16(kf[1],qr[0],f32x16{},0,0,0), P0[6],P0[7],P0[8],P0[9],     pw0[2]=PKW(P0,4), pw0[3]=PKW(P0,6), pw0); \
    VRDW(2); SBAR(); GAPA(C0=__builtin_amdgcn_mfma_f32_32x32x16_bf16(kf[2],qr[1],C0,0,0,0),   P0[10],P0[11],P0[12],P0[13], pw1[0]=PKW(P0,8), pw1[1]=PKW(P0,10), pw1); \
    VRDW(3); SBAR(); GAPA(C1=__builtin_amdgcn_mfma_f32_32x32x16_bf16(kf[3],qr[1],C1,0,0,0),   P0[14],P0[15],P1[0],P1[1],   pw1[2]=PKW(P0,12),pw1[3]=PKW(P0,14), pw1); \
    GAPA(C0=__builtin_amdgcn_mfma_f32_32x32x16_bf16(kf[4],qr[2],C0,0,0,0),   P1[2],P1[3],P1[4],P1[5],     pw2[0]=PKW(P1,0), pw2[1]=PKW(P1,2), pw2); \
    GAPA(C1=__builtin_amdgcn_mfma_f32_32x32x16_bf16(kf[5],qr[2],C1,0,0,0),   P1[6],P1[7],P1[8],P1[9],     pw2[2]=PKW(P1,4), pw2[3]=PKW(P1,6), pw2); \
    GAPA(C0=__builtin_amdgcn_mfma_f32_32x32x16_bf16(kf[6],qr[3],C0,0,0,0),   P1[10],P1[11],P1[12],P1[13], pw3[0]=PKW(P1,8), pw3[1]=PKW(P1,10), pw3); \
    GAPA(C1=__builtin_amdgcn_mfma_f32_32x32x16_bf16(kf[7],qr[3],C1,0,0,0),   P1[14],P1[15],0.f,0.f,       pw3[2]=PKW(P1,12),pw3[3]=PKW(P1,14), pw3); \
    l_reg+=sacc; \
    _Pragma("unroll") for(int r=0;r<16;++r){C0[r]-=mhat;C1[r]-=mhat;} \
    if(GK){DMA_K((t)+3,sl_cur);} if(GV){DMA_V((t)+1,sl_next);} \
    CMASK(C0,C1,t); \
    { float a=MX3(C0[0],C0[1],C1[0]),b=MX3(C0[2],C0[3],C1[1]); a=MX3(a,C1[2],C1[3]); \
      _Pragma("unroll") for(int r=4;r<16;r+=4){a=MX3(a,C0[r],C0[r+1]);b=MX3(b,C0[r+2],C0[r+3]);a=MX3(a,C1[r],C1[r+1]);b=MX3(b,C1[r+2],C1[r+3]);} \
      float rm=__builtin_fmaxf(a,b); { auto rr=__builtin_amdgcn_permlane32_swap(__float_as_uint(rm),__float_as_uint(rm),false,false); rm=__builtin_fmaxf(__uint_as_float(rr[0]),__uint_as_float(rr[1])); } \
      resc=false; \
      if(__builtin_expect(__any(rm>(float)THRL),0)){ const float dl=__builtin_fmaxf(rm,0.f); mhat+=dl; \
        _Pragma("unroll") for(int r=0;r<16;++r){C0[r]-=dl;C1[r]-=dl;} \
        const float f=__builtin_amdgcn_exp2f(-dl); l_reg*=f; if(hi==0)wsf[r32]=f; resc=true; } } \
    SBAR(); \
    GAPB(o[0]=__builtin_amdgcn_mfma_f32_32x32x16_bf16(PAF(0),VFRW(0),o[0],0,0,0), C0,0);  VRDW(4);  SBAR(); \
    GAPB(o[1]=__builtin_amdgcn_mfma_f32_32x32x16_bf16(PAF(0),VFRW(1),o[1],0,0,0), C0,2);  VRDW(5);  SBAR(); \
    KRD(GL,0); GAPB(o[0]=__builtin_amdgcn_mfma_f32_32x32x16_bf16(PAF(1),VFRW(2),o[0],0,0,0), C0,4);  VRDW(6);  SBAR(); \
    KRD(GL,1); GAPB(o[1]=__builtin_amdgcn_mfma_f32_32x32x16_bf16(PAF(1),VFRW(3),o[1],0,0,0), C0,6);  VRDW(7);  SBAR(); \
    KRD(GL,2); GAPB(o[0]=__builtin_amdgcn_mfma_f32_32x32x16_bf16(PAF(2),VFRW(0),o[0],0,0,0), C0,8);  VRDW(8);  SBAR(); \
    KRD(GL,3); GAPB(o[1]=__builtin_amdgcn_mfma_f32_32x32x16_bf16(PAF(2),VFRW(1),o[1],0,0,0), C0,10); VRDW(9);  SBAR(); \
    GAPB(o[0]=__builtin_amdgcn_mfma_f32_32x32x16_bf16(PAF(3),VFRW(2),o[0],0,0,0), C0,12); VRDW(10); SBAR(); \
    GAPB(o[1]=__builtin_amdgcn_mfma_f32_32x32x16_bf16(PAF(3),VFRW(3),o[1],0,0,0), C0,14); VRDW(11); SBAR(); \
    GAPB(o[2]=__builtin_amdgcn_mfma_f32_32x32x16_bf16(PAF(0),VFRW(0),o[2],0,0,0), C1,0);  VRDW(12); SBAR(); \
    GAPB(o[3]=__builtin_amdgcn_mfma_f32_32x32x16_bf16(PAF(0),VFRW(1),o[3],0,0,0), C1,2);  VRDW(13); SBAR(); \
    GAPB(o[2]=__builtin_amdgcn_mfma_f32_32x32x16_bf16(PAF(1),VFRW(2),o[2],0,0,0), C1,4);  VRDW(14); SBAR(); \
    GAPB(o[3]=__builtin_amdgcn_mfma_f32_32x32x16_bf16(PAF(1),VFRW(3),o[3],0,0,0), C1,6);  VRDW(15); SBAR(); \
    GAPB(o[2]=__builtin_amdgcn_mfma_f32_32x32x16_bf16(PAF(2),VFRW(0),o[2],0,0,0), C1,8); \
    GAPB(o[3]=__builtin_amdgcn_mfma_f32_32x32x16_bf16(PAF(2),VFRW(1),o[3],0,0,0), C1,10); \
    GAPB(o[2]=__builtin_amdgcn_mfma_f32_32x32x16_bf16(PAF(3),VFRW(2),o[2],0,0,0), C1,12); \
    GAPB(o[3]=__builtin_amdgcn_mfma_f32_32x32x16_bf16(PAF(3),VFRW(3),o[3],0,0,0), C1,14); \
    }while(0)
  int t=1;
  #undef CMASK
  #define CMASK(P0,P1,t) do{}while(0)
  for(;t+5<NT;t+=2){
    STEP(pB0,pB1,pA0,pA1,t,true,true,true);     WAIT_BAR(3); RESC(); ROT();
    STEP(pA0,pA1,pB0,pB1,t+1,true,true,true);   WAIT_BAR(3); RESC(); ROT();
  }
  #undef CMASK
  #define CMASK(P0,P1,t) do{int jb_=(t)-(NT-4); if(jb_>=0)cmask(P0,P1,jb_,qrel,hi);}while(0)
  #define ENDW(tt) do{ if((tt)+3<NT){WAIT_BAR(3);} else if((tt)+2<NT){WAIT_BAR(2);} else {WAIT_BAR(0);} }while(0)
  for(;t+1<NT;t+=2){
    STEP(pB0,pB1,pA0,pA1,t,(t+3<NT),(t+1<NT),(t+1<NT));       ENDW(t);   RESC(); ROT();
    STEP(pA0,pA1,pB0,pB1,t+1,(t+4<NT),(t+2<NT),(t+2<NT));     ENDW(t+1); RESC(); ROT();
  }
  STEP(pB0,pB1,pA0,pA1,NT-1,false,false,false); RESC();
  { float sacc=pB0[0]+pB0[1]; _Pragma("unroll") for(int r=2;r<16;++r)sacc+=pB0[r]; _Pragma("unroll") for(int r=0;r<16;++r)sacc+=pB1[r]; l_reg+=sacc;
    pw0=(u32x4){PKW(pB0,0),PKW(pB0,2),PKW(pB0,4),PKW(pB0,6)};pw1=(u32x4){PKW(pB0,8),PKW(pB0,10),PKW(pB0,12),PKW(pB0,14)};pw2=(u32x4){PKW(pB1,0),PKW(pB1,2),PKW(pB1,4),PKW(pB1,6)};pw3=(u32x4){PKW(pB1,8),PKW(pB1,10),PKW(pB1,12),PKW(pB1,14)};
    SBAR(); pv(o,vb0+2*sl_cur,PAF(0),PAF(1),PAF(2),PAF(3)); }
  #undef PKW
  #undef PAF
  #undef VFRW
  #undef VOFF
  #undef PIN
  #undef MX3
  #undef GAPA
  #undef GAPB
  #undef EX
  #undef VRDW
  #undef KRD
  #undef STEP
  #undef ENDW
  {auto rr=__builtin_amdgcn_permlane32_swap(__float_as_uint(l_reg),__float_as_uint(l_reg),false,false);l_reg=__uint_as_float(rr[0])+__uint_as_float(rr[1]);}
  if(hi==0)wsf[32+r32]=l_reg;asm volatile("s_waitcnt lgkmcnt(0)":::"memory");
  float rli[16];
  #pragma unroll
  for(int r=0;r<16;++r)rli[r]=__builtin_amdgcn_rcpf(wsf[32+crow(r,hi)]);
  bf16*Ow=O+(rowbase+q0+wid*QBLK)*OPITCH;
  { bf16*stg=(bf16*)(shm+LDS_OST)+wid*4096;
    #pragma unroll
    for(int r=0;r<16;++r){const int orow=crow(r,hi);
      #pragma unroll
      for(int d0=0;d0<4;++d0)stg[orow*128+d0*32+r32]=__float2bfloat16(o[d0][r]*rli[r]);}
    asm volatile("s_waitcnt lgkmcnt(0)":::"memory");
    #pragma unroll
    for(int i=0;i<8;++i){const int row=i*4+(lane>>4),ch=lane&15; const u32x4 v=*(const u32x4*)(stg+row*128+ch*8); ATTN_STORE16(Ow+(long)row*OPITCH+ch*8,v);} }
  asm volatile("s_waitcnt lgkmcnt(0)\n\ts_barrier":::"memory");
  #undef DMA_K
  #undef DMA_V
  #undef CMASK
  #undef START
  #undef RESC
  #undef ROT
}
constexpr int ATTN_LDS_BYTES=LDS_BYTES;
#undef SBAR
#undef WAIT_BAR
}
#define LAS __attribute__((address_space(3)))
typedef unsigned short bf16;
typedef unsigned u32x4 __attribute__((ext_vector_type(4)));
typedef unsigned u32x2 __attribute__((ext_vector_type(2)));
typedef float f32x4 __attribute__((ext_vector_type(4)));
typedef float f32x2 __attribute__((ext_vector_type(2)));
typedef float f32x16 __attribute__((ext_vector_type(16)));
typedef short bf16x8 __attribute__((ext_vector_type(8)));
typedef __bf16 bf16x2_t __attribute__((ext_vector_type(2)));

constexpr int NWAVES = 8, NTHR = 512;
constexpr int MT = 16384, DMOD = 2048, SEQL = 4096, IN0W = 7168;
constexpr float EPS = 1e-6f;
constexpr size_t MiB = 1u << 20;
constexpr size_t WS_LAM32 = 64 * 1024;
constexpr size_t WS_R0 = 192 * 1024;
constexpr size_t WS_SUMSQ = 128 * 1024, WS_ZERO_BYTES = 192 * 1024;
constexpr size_t WS_ROT = 1 * MiB;
constexpr size_t WS_WIN0 = 2 * MiB, WS_WOUT0 = 30 * MiB, WS_WIN1 = 38 * MiB, WS_WGLU = 54 * MiB, WS_WOUT1 = 62 * MiB;
constexpr size_t WS_TF = 70 * MiB, WS_WF = 74 * MiB, WS_VF = 90 * MiB;
constexpr size_t WS_H = 112 * MiB;
constexpr size_t WS_PROJ = 176 * MiB;
constexpr size_t WS_UGM = 176 * MiB, WS_GATE = 240 * MiB, WS_Z = 304 * MiB;
constexpr size_t WS_CAT = 400 * MiB;
constexpr size_t WS_OUT2 = 432 * MiB, WS_END = 496 * MiB;
constexpr int RING_BYTES = 131072, LDS_BYTES = 163840, MISC_OFF = LDS_BYTES - 512;
constexpr int NPH = 11;

__device__ __forceinline__ unsigned pkbf(float lo, float hi) { f32x2 v = {lo, hi}; bf16x2_t b = __builtin_convertvector(v, bf16x2_t); return __builtin_bit_cast(unsigned, b); }
__device__ __forceinline__ float bflo(unsigned u) { return __uint_as_float(u << 16); }
__device__ __forceinline__ float bfhi(unsigned u) { return __uint_as_float(u & 0xffff0000u); }
__device__ __forceinline__ float sigm(float x) { return __builtin_amdgcn_rcpf(1.0f + __expf(-x)); }
__device__ __forceinline__ float siluf(float x) { return x * sigm(x); }
__device__ __forceinline__ float gelu_tanh(float x) { return x * sigm(1.5957691216057308f * (x + 0.044715f * x * x * x)); }
__device__ __forceinline__ float wave_sum(float v) {
#pragma unroll
    for (int o = 1; o < 64; o <<= 1) v += __shfl_xor(v, o);
    return v;
}
__device__ __forceinline__ int crow(int r, int hi) { return (r & 3) + 8 * (r >> 2) + 4 * hi; }
__device__ __forceinline__ float red_frac(double th) { const double rev = th * 0.15915494309189535; return (float)(rev - rint(rev)); }
__device__ __forceinline__ float red_angle(double th) { const double rev = th * 0.15915494309189535; const double fr = rev - rint(rev); return (float)(fr * 6.283185307179586); }

typedef __attribute__((address_space(1))) unsigned gu32;
#define XB_TMO      128
#define XB_XCNT(j)  (256  + 64 * (j))
#define XB_XSUB(j)  (1280 + 64 * (j))
#define XB_XGEN(j)  (2304 + 64 * (j))
#define XB_TOP      3328
#define XB_TOPGEN   3392
#define XCD_BAR_WORDS 3456
#define XB_SPIN_CAP (1u << 18)

__device__ __forceinline__ unsigned xb_ld(unsigned* p)              { return __hip_atomic_load(p, __ATOMIC_RELAXED, __HIP_MEMORY_SCOPE_AGENT); }
__device__ __forceinline__ unsigned xb_add(unsigned* p, unsigned v) { return __hip_atomic_fetch_add(p, v, __ATOMIC_RELAXED, __HIP_MEMORY_SCOPE_AGENT); }
__device__ __forceinline__ unsigned xb_xcc_id() { return (unsigned)__builtin_amdgcn_s_getreg((3 << 11) | 20) & 0xFu; }
#define XB_SPIN(cond, bar) do { unsigned _sp = 0; while (cond) { __builtin_amdgcn_s_sleep(1); \
    if ((++_sp & 255u) == 0u) { if (xb_ld(&(bar)[XB_TMO])) break; if (_sp > XB_SPIN_CAP) { atomicAdd(&(bar)[XB_TMO], 1u); break; } } } } while (0)

struct XcdBarrier {
    unsigned* bar; unsigned x;
    volatile LAS unsigned* st;
};

__device__ __forceinline__ XcdBarrier xcd_barrier_post(unsigned* bar, volatile LAS unsigned* st) {
    XcdBarrier b; b.bar = bar; b.x = xb_xcc_id(); b.st = st;
    if (threadIdx.x == 0) (void)xb_add(&bar[XB_XCNT(b.x)], 1u);
    return b;
}
__device__ __forceinline__ void xcd_barrier_complete(unsigned* bar, unsigned x, unsigned& nloc, unsigned& nx) {
    const unsigned G = gridDim.x * gridDim.y * gridDim.z;
    unsigned sum, cnt, mine, sp = 0u;
    for (;;) {
        sum = 0u; cnt = 0u; mine = 0u;
#pragma unroll
        for (unsigned j = 0; j < 16; ++j) { const unsigned c = xb_ld(&bar[XB_XCNT(j)]); sum += c; cnt += (c > 0u) ? 1u : 0u; mine = (j == x) ? c : mine; }
        if (sum == G) break;
        __builtin_amdgcn_s_sleep(1);
        if ((++sp & 255u) == 0u) { if (xb_ld(&bar[XB_TMO])) break; if (sp > XB_SPIN_CAP) { atomicAdd(&bar[XB_TMO], 1u); break; } }
    }
    nloc = mine > 0u ? mine : 1u; nx = cnt > 0u ? cnt : 1u;
}

__device__ __forceinline__ void xcd_barrier(const XcdBarrier& b) {
    asm volatile("s_waitcnt vmcnt(0)" ::: "memory");
    __syncthreads();
    if (threadIdx.x == 0) {
        unsigned* bar = b.bar;
        __builtin_amdgcn_s_waitcnt(0);
        unsigned nloc = b.st[0], nx = b.st[1];
        if (nloc == 0u) { xcd_barrier_complete(bar, b.x, nloc, nx); b.st[0] = nloc; b.st[1] = nx; }
        const unsigned old = xb_add(&bar[XB_XSUB(b.x)], 1u);
        const unsigned gen = old / nloc;
        if (old + 1u == (gen + 1u) * nloc) {
            __builtin_amdgcn_fence(__ATOMIC_RELEASE, "agent");
            asm volatile("s_waitcnt vmcnt(0)" ::: "memory");
            const unsigned og = xb_add(&bar[XB_TOP], 1u);
            const unsigned tg = og / nx;
            if (og + 1u == (tg + 1u) * nx) xb_add(&bar[XB_TOPGEN], 1u);
            else XB_SPIN(xb_ld(&bar[XB_TOPGEN]) == tg, bar);
            __builtin_amdgcn_fence(__ATOMIC_ACQUIRE, "agent");
            xb_add(&bar[XB_XGEN(b.x)], 1u);
            asm volatile("s_waitcnt vmcnt(0)" ::: "memory");
        } else {
            XB_SPIN(xb_ld(&bar[XB_XGEN(b.x)]) == gen, bar);
            __builtin_amdgcn_fence(__ATOMIC_ACQUIRE, "agent");
            asm volatile("s_waitcnt vmcnt(0)" ::: "memory");
        }
    }
    __syncthreads();
}

struct Args { const float* in[28]; float* out; unsigned char* ws; int ph_lo, ph_hi, mask, pad; };

__device__ __forceinline__ void p0_transpose_item(const float* W, int K, int N, bf16* WT, LAS float* scr, int item, int lane, const float* gk = nullptr, bool glu_perm = false) {
    const int nblk = N / 32, kb = item / nblk, nb = item % nblk, k0 = 64 * kb, n0 = 32 * nb;
    float tv[32];
#pragma unroll
    for (int i = 0; i < 32; ++i) tv[i] = W[(size_t)(k0 + 2 * i + (lane >> 5)) * N + n0 + (lane & 31)];
    if (gk) {
#pragma unroll
        for (int i = 0; i < 32; ++i) tv[i] *= gk[k0 + 2 * i + (lane >> 5)]; }
#pragma unroll
    for (int i = 0; i < 32; ++i) scr[(2 * i + (lane >> 5)) * 33 + (lane & 31)] = tv[i];
    asm volatile("s_waitcnt lgkmcnt(0)" ::: "memory");
    const int c = lane & 7;
#pragma unroll
    for (int j = 0; j < 4; ++j) { const int n = (lane >> 3) + 8 * j; const LAS float* s = scr + (8 * c) * 33 + n;
        u32x4 o; o.x = pkbf(s[0 * 33], s[1 * 33]); o.y = pkbf(s[2 * 33], s[3 * 33]); o.z = pkbf(s[4 * 33], s[5 * 33]); o.w = pkbf(s[6 * 33], s[7 * 33]);
        const int nb0 = !glu_perm || n0 >= 2048 ? n0 : (n0 < 1024 ? 256 * (n0 >> 7) + (n0 & 127) : 256 * ((n0 - 1024) >> 7) + 128 + (n0 & 127));
        *(u32x4*)(WT + (size_t)(nb0 + n) * K + k0 + 8 * c) = o; }
    asm volatile("s_waitcnt lgkmcnt(0)" ::: "memory");
}
__device__ __forceinline__ void row_to_bf16_rs(const float* xrow, bf16* orow, float* rs, int lane) {
    const f32x4* xr = (const f32x4*)xrow + lane;
    f32x4 v[8]; float s = 0.f;
#pragma unroll
    for (int j = 0; j < 8; ++j) { v[j] = xr[64 * j]; s += (v[j].x * v[j].x + v[j].y * v[j].y) + (v[j].z * v[j].z + v[j].w * v[j].w); }
    const float r = 1.0f / sqrtf(wave_sum(s) * (1.0f / DMOD) + EPS);
    if (lane == 0) *rs = r;
    u32x2* o8 = (u32x2*)orow + lane;
#pragma unroll
    for (int j = 0; j < 8; ++j) { u32x2 w; w.x = pkbf(v[j].x, v[j].y); w.y = pkbf(v[j].z, v[j].w); o8[64 * j] = w; }
}
__device__ __forceinline__ void s5_tables(const Args& a, LAS unsigned char* lds, int g, int part, int tid) {
    LAS float* POWr = (LAS float*)lds;
    LAS float* POWi = POWr + 33 * 64;
    LAS float* BBr = POWi + 33 * 64;
    LAS float* BBi = BBr + 1024;
    LAS float* Cr = BBi + 1024;
    LAS float* Ci = Cr + 1024;
    LAS float* KL = Ci + 1024;
    const float* a_re = a.in[17] + g * 64; const float* a_im = a.in[18] + g * 64;
    const float dt = expf(a.in[19][g]);
    for (int idx = tid; idx < 33 * 64; idx += NTHR) { const int k = idx >> 6, p = idx & 63;
        const float ar = a_re[p], ai = a_im[p]; const float mag = expf(ar * dt * (float)k);
        const float fr = red_frac((double)ai * (double)dt * (double)k);
        POWr[idx] = mag * __builtin_amdgcn_cosf(fr); POWi[idx] = mag * __builtin_amdgcn_sinf(fr); }
    for (int idx = tid; idx < 1024; idx += NTHR) { const int p = idx >> 4;
        const float ar = a_re[p], ai = a_im[p];
        const float em1 = expm1f(ar * dt); const float ang = red_angle((double)ai * (double)dt);
        const float sn = sinf(ang), cs = cosf(ang), sh = sinf(0.5f * ang);
        const float nr = em1 * cs - 2.0f * sh * sh, ni = (em1 + 1.0f) * sn;
        const float den = ar * ar + ai * ai; const float fr = (nr * ar + ni * ai) / den, fi = (ni * ar - nr * ai) / den;
        const float br = a.in[20][(size_t)g * 1024 + idx], bi = a.in[21][(size_t)g * 1024 + idx];
        BBr[idx] = fr * br - fi * bi; BBi[idx] = fr * bi + fi * br;
        Cr[idx] = a.in[22][(size_t)g * 1024 + idx]; Ci[idx] = a.in[23][(size_t)g * 1024 + idx]; }
    __syncthreads();
    if (part == 0) {
        const int lag = tid >> 4, m = tid & 15; float acc[16];
#pragma unroll
        for (int q = 0; q < 16; ++q) acc[q] = 0.f;
        for (int p = 0; p < 64; ++p) { const float cr = Cr[m * 64 + p], ci = Ci[m * 64 + p], pr = POWr[lag * 64 + p], pi = POWi[lag * 64 + p];
            const float gr = cr * pr - ci * pi, gi = cr * pi + ci * pr;
#pragma unroll
            for (int q4 = 0; q4 < 4; ++q4) { const f32x4 b_r = *(const LAS f32x4*)(BBr + p * 16 + 4 * q4), b_i = *(const LAS f32x4*)(BBi + p * 16 + 4 * q4);
#pragma unroll
                for (int e = 0; e < 4; ++e) acc[4 * q4 + e] += gr * b_r[e] - gi * b_i[e]; } }
#pragma unroll
        for (int q = 0; q < 16; ++q) KL[(lag * 16 + m) * 16 + q] = acc[q];
    }
    __syncthreads();
    bf16* TF = (bf16*)(a.ws + WS_TF) + (size_t)g * 32 * 64 * 8;
    if (part == 0) for (int idx = tid; idx < 32 * 64; idx += NTHR) { const int dd = idx >> 6, lane = idx & 63, n = lane & 31, kh = lane >> 5; const int lag = dd - 1 + (n >> 4), m = n & 15;
        float v[8];
#pragma unroll
        for (int j = 0; j < 8; ++j) v[j] = (lag >= 0 && lag < 32) ? KL[(lag * 16 + m) * 16 + 8 * kh + j] : 0.f;
        u32x4 w; w.x = pkbf(v[0], v[1]); w.y = pkbf(v[2], v[3]); w.z = pkbf(v[4], v[5]); w.w = pkbf(v[6], v[7]);
        *(u32x4*)(TF + (size_t)idx * 8) = w; }
    bf16* WF = (bf16*)(a.ws + WS_WF) + (size_t)g * 32 * 4 * 64 * 8;
    if (part == 1) for (int idx = tid; idx < 32 * 4 * 64; idx += NTHR) { const int sp = idx >> 8, nt = (idx >> 6) & 3, lane = idx & 63, n = lane & 31, kh = lane >> 5;
        const int pp = 32 * nt + n, p = pp & 63, comp = pp >> 6, k = 31 - sp; const float pr = POWr[k * 64 + p], pi = POWi[k * 64 + p];
        float v[8];
#pragma unroll
        for (int j = 0; j < 8; ++j) { const float br = BBr[p * 16 + 8 * kh + j], bi = BBi[p * 16 + 8 * kh + j]; v[j] = comp ? (pr * bi + pi * br) : (pr * br - pi * bi); }
        u32x4 w; w.x = pkbf(v[0], v[1]); w.y = pkbf(v[2], v[3]); w.z = pkbf(v[4], v[5]); w.w = pkbf(v[6], v[7]);
        *(u32x4*)(WF + (size_t)idx * 8) = w; }
    bf16* VF = (bf16*)(a.ws + WS_VF) + (size_t)g * 16 * 8 * 64 * 8;
    if (part == 1) for (int idx = tid; idx < 16 * 8 * 64; idx += NTHR) { const int jt = idx >> 9, kk = (idx >> 6) & 7, lane = idx & 63, n = lane & 31, kh = lane >> 5;
        const int s = 2 * jt + (n >> 4), m = n & 15;
        float v[8];
#pragma unroll
        for (int j = 0; j < 8; ++j) { const int pp = 16 * kk + 8 * kh + j, p = pp & 63, comp = pp >> 6;
            const float pr = POWr[(s + 1) * 64 + p], pi = POWi[(s + 1) * 64 + p], cr = Cr[m * 64 + p], ci = Ci[m * 64 + p];
            v[j] = comp ? -(cr * pi + ci * pr) : (cr * pr - ci * pi); }
        u32x4 w; w.x = pkbf(v[0], v[1]); w.y = pkbf(v[2], v[3]); w.z = pkbf(v[4], v[5]); w.w = pkbf(v[6], v[7]);
        *(u32x4*)(VF + (size_t)idx * 8) = w; }
    if (part == 0 && tid < 64) { f32x2* L = (f32x2*)(a.ws + WS_LAM32) + g * 64 + tid; *L = (f32x2){POWr[32 * 64 + tid], POWi[32 * 64 + tid]}; }
    __syncthreads();
}

__device__ __forceinline__ void p0_prologue(const Args& a, LAS unsigned char* lds, int tid, int lane, int wave, int G) {
    if (a.mask & 4) for (int it = blockIdx.x; it < 256; it += G) s5_tables(a, lds, it & 127, it >> 7, tid);
    if (a.mask & 8) {
        f32x2* ROT = (f32x2*)(a.ws + WS_ROT);
        for (int idx = blockIdx.x * NTHR + tid; idx < SEQL * 32; idx += G * NTHR) { const int pos = idx >> 5, i = idx & 31;
            const float freq = exp2f(-(float)i * (13.287712379549449f / 32.0f));
            const float ang = red_angle((double)pos * (double)freq);
            ROT[idx] = (f32x2){cosf(ang), sinf(ang)}; }
    }
    LAS float* scr = (LAS float*)(lds + wave * 16384);
    const int gw = blockIdx.x * NWAVES + wave, NGW = G * NWAVES;
    constexpr int I0 = 32 * (IN0W / 32), I1 = 32 * (2048 / 32), I2 = 32 * (4096 / 32);
    constexpr int NITEMS = I0 + I1 + I2 + I1 + I1;
    if (a.mask & 16) for (int it = gw; it < NITEMS; it += NGW) {
        int r = it;
        if (r < I0) { p0_transpose_item(a.in[2], 2048, IN0W, (bf16*)(a.ws + WS_WIN0), scr, r, lane, a.in[1], true); continue; } r -= I0;
        if (r < I1) { p0_transpose_item(a.in[14], 2048, 2048, (bf16*)(a.ws + WS_WOUT0), scr, r, lane); continue; } r -= I1;
        if (r < I2) { p0_transpose_item(a.in[16], 2048, 4096, (bf16*)(a.ws + WS_WIN1), scr, r, lane, a.in[15]); continue; } r -= I2;
        if (r < I1) { p0_transpose_item(a.in[25], 2048, 2048, (bf16*)(a.ws + WS_WGLU), scr, r, lane); continue; } r -= I1;
        p0_transpose_item(a.in[27], 2048, 2048, (bf16*)(a.ws + WS_WOUT1), scr, r, lane);
    }
    if (a.mask & 32) for (int m = gw; m < MT; m += NGW) row_to_bf16_rs(a.in[0] + (size_t)m * DMOD, (bf16*)(a.ws + WS_H) + (size_t)m * DMOD, (float*)(a.ws + WS_R0) + m, lane);
}

struct QKIn { u32x4 x[4]; f32x4 rot[4]; };
__device__ __forceinline__ void qk_load(QKIn& in, const Args& a, int row, int lane) {
    const bf16* base = (const bf16*)(a.ws + WS_PROJ) + (size_t)row * IN0W + 3072 + (lane >> 2) * 64 + (lane & 3) * 8;
    in.x[0] = *(const u32x4*)base; in.x[1] = *(const u32x4*)(base + 32); in.x[2] = *(const u32x4*)(base + 1024); in.x[3] = *(const u32x4*)(base + 1024 + 32);
    const f32x4* rot = (const f32x4*)((const f32x2*)(a.ws + WS_ROT) + (row & (SEQL - 1)) * 32 + (lane & 3) * 8);
#pragma unroll
    for (int q = 0; q < 4; ++q) in.rot[q] = rot[q];
}
__device__ __forceinline__ void qk_finish(const QKIn& in, const Args& a, int row, int lane) {
    float gq[16], gk[16]; { const int i0 = (lane & 3) * 8;
#pragma unroll
        for (int j = 0; j < 8; ++j) { gq[j] = a.in[7][i0 + j]; gq[8 + j] = a.in[7][32 + i0 + j]; gk[j] = a.in[8][i0 + j]; gk[8 + j] = a.in[8][32 + i0 + j]; } }
    bf16* base = (bf16*)(a.ws + WS_PROJ) + (size_t)row * IN0W + 3072 + (lane >> 2) * 64 + (lane & 3) * 8;
#pragma unroll
    for (int which = 0; which < 2; ++which) { const u32x4 x1 = in.x[2 * which], x2 = in.x[2 * which + 1];
        float f1[8], f2[8]; float ss = 0.f;
#pragma unroll
        for (int q = 0; q < 4; ++q) { f1[2 * q] = bflo(x1[q]); f1[2 * q + 1] = bfhi(x1[q]); f2[2 * q] = bflo(x2[q]); f2[2 * q + 1] = bfhi(x2[q]); }
#pragma unroll
        for (int j = 0; j < 8; ++j) ss += f1[j] * f1[j] + f2[j] * f2[j];
        ss += __shfl_xor(ss, 1); ss += __shfl_xor(ss, 2);
        const float sc = __builtin_amdgcn_rsqf(ss * (1.0f / 64.0f) + EPS) * (which == 0 ? 0.125f * 1.4426950408889634f : 1.0f);
        float o1[8], o2[8];
#pragma unroll
        for (int j = 0; j < 8; ++j) { const float y1 = f1[j] * sc * (which == 0 ? gq[j] : gk[j]), y2 = f2[j] * sc * (which == 0 ? gq[8 + j] : gk[8 + j]);
            const float cs = in.rot[j >> 1][2 * (j & 1)], sn = in.rot[j >> 1][2 * (j & 1) + 1];
            o1[j] = y1 * cs - y2 * sn; o2[j] = y2 * cs + y1 * sn; }
        u32x4 w1, w2;
#pragma unroll
        for (int q = 0; q < 4; ++q) { w1[q] = pkbf(o1[2 * q], o1[2 * q + 1]); w2[q] = pkbf(o2[2 * q], o2[2 * q + 1]); }
        *(u32x4*)(base + which * 1024) = w1; *(u32x4*)(base + which * 1024 + 32) = w2; }
}
__device__ __forceinline__ void mixer_a_unit(const Args& a, LAS unsigned char* lds, int unit, int tid, int lane, int wave, int qrow) {
    const int t0 = unit * 32, s0 = t0 & (SEQL - 1);
    const bf16* PROJ = (const bf16*)(a.ws + WS_PROJ);
    QKIn qin[2];
    if (qrow >= 0) { qk_load(qin[0], a, qrow, lane); qk_load(qin[1], a, qrow + 1, lane); }
#pragma unroll 8
    for (int idx = tid; idx < 62 * 128; idx += NTHR) { const int r = idx >> 7, ch = (idx & 127) * 8; u32x4 w = {0u, 0u, 0u, 0u};
        if (s0 - 30 + r >= 0) w = *(const u32x4*)(PROJ + (size_t)(t0 - 30 + r) * IN0W + ch);
        *(LAS u32x4*)(lds + r * 2048 + ch * 2) = w; }
    if (qrow >= 0) { qk_finish(qin[0], a, qrow, lane); __builtin_amdgcn_sched_barrier(0); qk_finish(qin[1], a, qrow + 1, lane); __builtin_amdgcn_sched_barrier(0); }
    __syncthreads();
    {
        f32x2 P[31], w[31];
        const f32x2 cb = *(const f32x2*)(a.in[4] + 2 * tid);
        const float* wp = a.in[3] + 2 * tid; asm volatile("" : "+v"(wp));
#pragma unroll
        for (int j = 0; j < 31; ++j) { P[j] = cb; w[j] = *(const f32x2*)(wp + j * 1024); }
#define CROW(Q, RHO) { const int r = (Q) * 31 + (RHO); const unsigned uw = *(const LAS unsigned*)(lds + r * 2048 + tid * 4); const f32x2 uv = {bflo(uw), bfhi(uw)}; \
        _Pragma("unroll") for (int j = 0; j < 31; ++j) { if ((Q) == 0 ? (j <= (RHO)) : (j >= (RHO))) P[((RHO) - j + 31) % 31] += w[j] * uv; } \
        if (r >= 30) { *(LAS unsigned*)(lds + (r - 30) * 2048 + tid * 4) = pkbf(P[((RHO) + 1) % 31].x, P[((RHO) + 1) % 31].y); P[((RHO) + 1) % 31] = cb; } \
        if (((RHO) & 3) == 3) __builtin_amdgcn_sched_barrier(0); }
#define CROWS(Q) CROW(Q, 0) CROW(Q, 1) CROW(Q, 2) CROW(Q, 3) CROW(Q, 4) CROW(Q, 5) CROW(Q, 6) CROW(Q, 7) CROW(Q, 8) CROW(Q, 9) CROW(Q, 10) CROW(Q, 11) CROW(Q, 12) CROW(Q, 13) CROW(Q, 14) CROW(Q, 15) \
        CROW(Q, 16) CROW(Q, 17) CROW(Q, 18) CROW(Q, 19) CROW(Q, 20) CROW(Q, 21) CROW(Q, 22) CROW(Q, 23) CROW(Q, 24) CROW(Q, 25) CROW(Q, 26) CROW(Q, 27) CROW(Q, 28) CROW(Q, 29) CROW(Q, 30)
        CROWS(0)
        __builtin_amdgcn_sched_barrier(0);
        CROWS(1)
#undef CROWS
#undef CROW
    }
    asm volatile("" ::: "memory"); __builtin_amdgcn_sched_barrier(0);
    if (qrow >= 0) { qk_load(qin[0], a, qrow + 2, lane); qk_load(qin[1], a, qrow + 3, lane); }
    __syncthreads();
    bf16* CAT = (bf16*)(a.ws + WS_CAT);
    {
        u32x4 gt[4][2]; float gg[16], bb[16];
#pragma unroll
        for (int q = 0; q < 4; ++q)
#pragma unroll
            for (int j = 0; j < 2; ++j) gt[q][j] = *(const u32x4*)(PROJ + (size_t)(t0 + wave * 4 + q) * IN0W + 2048 + 512 * j + lane * 8);
#pragma unroll
        for (int j = 0; j < 2; ++j)
#pragma unroll
            for (int e4 = 0; e4 < 2; ++e4) { const f32x4 g4 = *(const f32x4*)(a.in[5] + 512 * j + lane * 8 + 4 * e4), b4 = *(const f32x4*)(a.in[6] + 512 * j + lane * 8 + 4 * e4);
#pragma unroll
                for (int e = 0; e < 4; ++e) { gg[8 * j + 4 * e4 + e] = g4[e]; bb[8 * j + 4 * e4 + e] = b4[e]; } }
#pragma unroll
        for (int q = 0; q < 4; ++q) { const int i = wave * 4 + q; float v[16]; float s = 0.f;
#pragma unroll
            for (int j = 0; j < 2; ++j) { const u32x4 cw = *(const LAS u32x4*)(lds + i * 2048 + (512 * j + lane * 8) * 2);
#pragma unroll
                for (int e = 0; e < 4; ++e) { v[8 * j + 2 * e] = bflo(cw[e]); v[8 * j + 2 * e + 1] = bfhi(cw[e]); } }
#pragma unroll
            for (int e = 0; e < 16; ++e) s += v[e];
            const float mean = wave_sum(s) * (1.0f / 1024.0f); float s2 = 0.f;
#pragma unroll
            for (int e = 0; e < 16; ++e) { v[e] -= mean; s2 += v[e] * v[e]; }
            const float rstd = __builtin_amdgcn_rsqf(wave_sum(s2) * (1.0f / 1024.0f) + EPS);
            const size_t row = (size_t)(t0 + i);
#pragma unroll
            for (int j = 0; j < 2; ++j) { u32x4 o;
#pragma unroll
                for (int e = 0; e < 4; ++e) { const float y0 = v[8 * j + 2 * e] * rstd * gg[8 * j + 2 * e] + bb[8 * j + 2 * e], y1 = v[8 * j + 2 * e + 1] * rstd * gg[8 * j + 2 * e + 1] + bb[8 * j + 2 * e + 1];
                    o[e] = pkbf(siluf(y0) * bflo(gt[q][j][e]), siluf(y1) * bfhi(gt[q][j][e])); }
                *(u32x4*)(CAT + row * DMOD + 512 * j + lane * 8) = o; }
            __builtin_amdgcn_sched_barrier(0); }
    }
    if (qrow >= 0) { qk_finish(qin[0], a, qrow + 2, lane); __builtin_amdgcn_sched_barrier(0); qk_finish(qin[1], a, qrow + 3, lane); }
    __syncthreads();
}
__device__ __forceinline__ void qk_prep_phase(const Args& a, int gw, int NGW, int lane) {
#pragma unroll 1
    for (int r0 = gw * 4; r0 < MT; r0 += NGW * 4) { QKIn in[4];
#pragma unroll
        for (int q = 0; q < 4; ++q) qk_load(in[q], a, r0 + q, lane);
#pragma unroll
        for (int q = 0; q < 4; ++q) { qk_finish(in[q], a, r0 + q, lane); __builtin_amdgcn_sched_barrier(0); } }
}
struct CbIn { u32x4 a0[2], a1[2], bg[2]; };
__device__ __forceinline__ void cb_load(CbIn& in, const Args& a, int row, int lane) {
#pragma unroll
    for (int hg = 0; hg < 2; ++hg) { const int h = hg * 4 + (lane >> 4), j0 = (lane & 15) * 8;
        const bf16* OP = (const bf16*)(a.ws + WS_PROJ) + (size_t)row * IN0W + h * 128 + j0;
        in.a0[hg] = *(const u32x4*)OP; in.a1[hg] = *(const u32x4*)(OP + 1024);
        in.bg[hg] = *(const u32x4*)((const bf16*)(a.ws + WS_PROJ) + (size_t)row * IN0W + 6144 + h * 128 + j0); }
}
__device__ __forceinline__ void cb_finish(const CbIn& in, const Args& a, int row, int lane, float lam, const float (&sg)[8]) {
#pragma unroll
    for (int hg = 0; hg < 2; ++hg) { const int h = hg * 4 + (lane >> 4), j0 = (lane & 15) * 8;
        float o[8]; float ss = 0.f;
#pragma unroll
        for (int q = 0; q < 4; ++q) { o[2 * q] = bflo(in.a0[hg][q]) - lam * bflo(in.a1[hg][q]); o[2 * q + 1] = bfhi(in.a0[hg][q]) - lam * bfhi(in.a1[hg][q]); }
#pragma unroll
        for (int j = 0; j < 8; ++j) ss += o[j] * o[j];
        ss += __shfl_xor(ss, 1); ss += __shfl_xor(ss, 2); ss += __shfl_xor(ss, 4); ss += __shfl_xor(ss, 8);
        const float r = __builtin_amdgcn_rsqf(ss * (1.0f / 128.0f) + EPS) * 0.8f;
        u32x4 w;
#pragma unroll
        for (int q = 0; q < 4; ++q) w[q] = pkbf(o[2 * q] * r * sg[2 * q] * bflo(in.bg[hg][q]), o[2 * q + 1] * r * sg[2 * q + 1] * bfhi(in.bg[hg][q]));
        *(u32x4*)((bf16*)(a.ws + WS_CAT) + (size_t)row * DMOD + 1024 + h * 128 + j0) = w; }
}
__device__ __forceinline__ void combine_phase(const Args& a, int gw, int NGW, int lane, float lam) {
    float sg[8];
#pragma unroll
    for (int j = 0; j < 8; ++j) sg[j] = a.in[13][(lane & 15) * 8 + j];
#pragma unroll 1
    for (int r0 = gw * 4; r0 < MT; r0 += NGW * 4) { CbIn in[4];
#pragma unroll
        for (int q = 0; q < 4; ++q) cb_load(in[q], a, r0 + q, lane);
#pragma unroll
        for (int q = 0; q < 4; ++q) { cb_finish(in[q], a, r0 + q, lane, lam, sg); __builtin_amdgcn_sched_barrier(0); } }
}

constexpr int UPITCH = 1040, HPITCH = 272, S5_UIMG = 0, S5_HIMG = 64 * UPITCH, S5_EBUF = S5_HIMG + 64 * HPITCH, S5_TF = S5_EBUF + 32768, S5_END = S5_TF + 32768;
#define S5_ITEM(step) (bx + ((step) >> 1) * G)
#define S5_USRC(step) ((const u32x4*)((const bf16*)(a.ws + WS_UGM) + ((size_t)(S5_ITEM(step) & 127) * MT + (size_t)(S5_ITEM(step) >> 7) * SEQL + ((step) & 1) * 2048) * 16))
__device__ __forceinline__ void s5_phase(const Args& a, LAS unsigned char* lds, int bx, int G, int tid, int lane, int wave) {
    const int r32 = lane & 31, hi = lane >> 5;
    int nsteps = 0; for (int it = bx; it < 512; it += G) nsteps += 2;
    if (nsteps == 0) return;
    u32x4 upre[8];
    { const u32x4* src = S5_USRC(0);
#pragma unroll
      for (int ps = 0; ps < 8; ++ps) upre[ps] = src[ps * NTHR + tid]; }
    float hr = 0.f, him = 0.f, dsk = 0.f; f32x2 l32 = {0.f, 0.f};
#pragma unroll 1
    for (int step = 0; step < nsteps; ++step) {
        const int item = S5_ITEM(step), g = item & 127, b = item >> 7, half = step & 1;
        const bf16x8* WF = (const bf16x8*)(a.ws + WS_WF) + (size_t)g * 32 * 4 * 64 + lane;
        const bf16x8* VF = (const bf16x8*)(a.ws + WS_VF) + (size_t)g * 16 * 8 * 64 + lane;
#pragma unroll
        for (int ps = 0; ps < 8; ++ps) { const int idx = ps * NTHR + tid; *(LAS u32x4*)(lds + S5_UIMG + (idx >> 6) * UPITCH + (idx & 63) * 16) = upre[ps]; }
        if (half == 0) {
            const u32x4* tsrc = (const u32x4*)(a.ws + WS_TF) + (size_t)g * 2048;
            u32x4 tv[4];
#pragma unroll
            for (int ps = 0; ps < 4; ++ps) tv[ps] = tsrc[ps * NTHR + tid];
            hr = 0.f; him = 0.f; dsk = a.in[24][g * 16 + (r32 & 15)];
            if (wave == 0) l32 = ((const f32x2*)(a.ws + WS_LAM32))[g * 64 + lane];
#pragma unroll
            for (int ps = 0; ps < 4; ++ps) *(LAS u32x4*)(lds + S5_TF + (ps * NTHR + tid) * 16) = tv[ps];
        }
        __syncthreads();
        {
            const int mt = wave >> 2, nt = wave & 3; f32x16 acc = {};
            const LAS unsigned char* ap = lds + S5_UIMG + (32 * mt + r32) * UPITCH + hi * 16;
#pragma unroll 16
            for (int sp = 0; sp < 32; ++sp) { const bf16x8 A = *(const LAS bf16x8*)(ap + sp * 32); const bf16x8 B = WF[(sp * 4 + nt) * 64];
                acc = __builtin_amdgcn_mfma_f32_32x32x16_bf16(A, B, acc, 0, 0, 0); }
            LAS float* E = (LAS float*)(lds + S5_EBUF);
#pragma unroll
            for (int i = 0; i < 16; ++i) E[(32 * mt + crow(i, hi)) * 128 + 32 * nt + r32] = acc[i];
        }
        __syncthreads();
        if (wave == 0) {
            const LAS float* E = (const LAS float*)(lds + S5_EBUF); LAS bf16* H = (LAS bf16*)(lds + S5_HIMG);
#pragma unroll 1
            for (int c0 = 0; c0 < 64; c0 += 8) { float er[8], ei[8];
#pragma unroll
                for (int q = 0; q < 8; ++q) { er[q] = E[(c0 + q) * 128 + lane]; ei[q] = E[(c0 + q) * 128 + 64 + lane]; }
#pragma unroll
                for (int q = 0; q < 8; ++q) { const unsigned pk = pkbf(hr, him); H[(c0 + q) * (HPITCH / 2) + lane] = (bf16)(pk & 0xffffu); H[(c0 + q) * (HPITCH / 2) + 64 + lane] = (bf16)(pk >> 16);
                    const float nr = l32.x * hr - l32.y * him + er[q], ni = l32.x * him + l32.y * hr + ei[q]; hr = nr; him = ni; } }
        }
        __syncthreads();
        f32x16 acc[2][2];
#pragma unroll
        for (int jj = 0; jj < 2; ++jj) { const int j = jj ? 15 - wave : wave; acc[jj][0] = (f32x16){}; acc[jj][1] = (f32x16){};
            bf16x8 vfr[8];
#pragma unroll
            for (int kk = 0; kk < 8; ++kk) vfr[kk] = VF[(j * 8 + kk) * 64];
            const LAS unsigned char* ap = lds + S5_UIMG + r32 * UPITCH + hi * 16; const LAS unsigned char* tp = lds + S5_TF + lane * 16; const int nks = 2 * j + 2;
#pragma unroll 4
            for (int sp = 0; sp < nks; ++sp) { const bf16x8 B = *(const LAS bf16x8*)(tp + (2 * j + 1 - sp) * 1024); const bf16x8 A0 = *(const LAS bf16x8*)(ap + sp * 32), A1 = *(const LAS bf16x8*)(ap + 32 * UPITCH + sp * 32);
                acc[jj][0] = __builtin_amdgcn_mfma_f32_32x32x16_bf16(A0, B, acc[jj][0], 0, 0, 0); acc[jj][1] = __builtin_amdgcn_mfma_f32_32x32x16_bf16(A1, B, acc[jj][1], 0, 0, 0); }
            const LAS unsigned char* hp = lds + S5_HIMG + r32 * HPITCH + hi * 16;
#pragma unroll
            for (int kk = 0; kk < 8; ++kk) { const bf16x8 A0 = *(const LAS bf16x8*)(hp + kk * 32), A1 = *(const LAS bf16x8*)(hp + 32 * HPITCH + kk * 32);
                acc[jj][0] = __builtin_amdgcn_mfma_f32_32x32x16_bf16(A0, vfr[kk], acc[jj][0], 0, 0, 0); acc[jj][1] = __builtin_amdgcn_mfma_f32_32x32x16_bf16(A1, vfr[kk], acc[jj][1], 0, 0, 0); }
        }
        if (step + 1 < nsteps) { const u32x4* src = S5_USRC(step + 1);
#pragma unroll
            for (int ps = 0; ps < 8; ++ps) upre[ps] = src[ps * NTHR + tid]; }
        __syncthreads();
#pragma unroll
        for (int jj = 0; jj < 2; ++jj) { const int j = jj ? 15 - wave : wave;
#pragma unroll
            for (int mt = 0; mt < 2; ++mt)
                { LAS bf16* ub = (LAS bf16*)(lds + S5_UIMG + (32 * mt + 4 * hi) * UPITCH + j * 64 + r32 * 2); unsigned short uu[16];
#pragma unroll
                    for (int i = 0; i < 16; ++i) uu[i] = ub[((i & 3) + 8 * (i >> 2)) * (UPITCH / 2)];
#pragma unroll
                    for (int i = 0; i < 16; ++i) { const float u = __uint_as_float((unsigned)uu[i] << 16); const float v = acc[jj][mt][i] + dsk * u; uu[i] = (unsigned short)(pkbf(gelu_tanh(v), 0.f) & 0xffffu); }
#pragma unroll
                    for (int i = 0; i < 16; ++i) ub[((i & 3) + 8 * (i >> 2)) * (UPITCH / 2)] = uu[i]; } }
        __syncthreads();
        { bf16* Z = (bf16*)(a.ws + WS_Z);
#pragma unroll
          for (int ps = 0; ps < 4; ++ps) { const int idx = ps * NTHR + tid; const LAS unsigned char* sp_ = lds + S5_UIMG + (idx >> 5) * UPITCH + (idx & 31) * 32;
            const u32x4 v0 = *(const LAS u32x4*)sp_, v1 = *(const LAS u32x4*)(sp_ + 16);
            bf16* dst = Z + (size_t)(b * SEQL + half * 2048 + idx) * DMOD + 16 * g; *(u32x4*)dst = v0; *(u32x4*)(dst + 8) = v1; } }
        __syncthreads();
    }
}

#ifndef MK_N_LAUNCHES
#define MK_N_LAUNCHES 1
#endif
__global__ void __launch_bounds__(NTHR, 2) fwd_kernel(Args a) {
    extern __shared__ __attribute__((aligned(16))) unsigned char lds_raw[];
    cg::grid_group grid = cg::this_grid();
    LAS unsigned char* lds = (LAS unsigned char*)lds_raw;
    const int tid = threadIdx.x, lane = tid & 63, wave = __builtin_amdgcn_readfirstlane(tid >> 6), G = gridDim.x;
    const int bx = blockIdx.x; const int vcu = (G % 8 == 0) ? (bx % 8) * (G / 8) + bx / 8 : bx;
    const int gw = bx * NWAVES + wave, NGW = G * NWAVES;
    const int lo = a.ph_lo, hi = a.ph_hi;
    unsigned char* ws = a.ws;
    volatile LAS unsigned* MISC = (volatile LAS unsigned*)(lds + MISC_OFF);
    if (tid < 32) MISC[tid] = 0u;
    __syncthreads();
    XcdBarrier bar = xcd_barrier_post((unsigned*)ws, MISC + 8);
#define IN(k) (lo <= (k) && (k) < hi)
#ifdef PROBE_A
#define STAMP(k) do { if (bx == 0 && tid == 0) ((unsigned long long*)(ws + 32768))[(k)] = __builtin_amdgcn_s_memrealtime(); } while (0)
#else
#define STAMP(k) do {} while (0)
#endif
#define SEAM(k) do { STAMP((k) + 1); if (IN(k) && IN((k) + 1)) { if ((k) == 0 && lo < 0) grid.sync(); else xcd_barrier(bar);     } } while (0)

    STAMP(0);
    if (IN(0)) { p0_prologue(a, lds, tid, lane, wave, G); }
#if defined(TWICE_P) && TWICE_P == 0
    __syncthreads(); p0_prologue(a, lds, tid, lane, wave, G);
#endif
    SEAM(0);
    if (IN(1)) {
        pg8::Gemm g{(const bf16*)(ws + WS_H), (const bf16*)(ws + WS_WIN0), MT, IN0W, DMOD}; pg8::StaticOrder S; S.init(MT, IN0W, G, bx);
        pg8::EpiBf16Row E{(bf16*)(ws + WS_PROJ), IN0W, (const float*)(ws + WS_R0)};
        pg8::gemm_phase<pg8::EpiBf16Row, pg8::StaticOrder, PG8_ALIGN, PG8_SP2>(lds, g, S, E);
    }
    SEAM(1);
    if (IN(2)) {
        const bool fuse = (G == 256) && (a.mask == -1);
        { int k = 0;
#pragma unroll 1
          for (int u = bx; u < MT / 32; u += G, ++k) { if (a.mask & 1) mixer_a_unit(a, lds, u, tid, lane, wave, fuse ? gw * 8 + k * 4 : -1); } }
        if (!fuse && (a.mask & 2)) qk_prep_phase(a, gw, NGW, lane);
    }
    SEAM(2);
#if defined(TWICE_P) && TWICE_P == 3
    for (int rep3 = 0; rep3 < 2; ++rep3)
#endif
    if (IN(3)) {
        const attn_body::bf16* PROJ = (const attn_body::bf16*)(ws + WS_PROJ); attn_body::bf16* OP = (attn_body::bf16*)(ws + WS_PROJ);
        const int per = (512 + G - 1) / G;
#pragma unroll 1
        for (int ui = 0; ui < 2 * per; ++ui) { const int pi = vcu * per + (ui >> 1); if (pi >= 512) break;
            const int bhc = pi >> 3, s = pi & 7, b = bhc >> 4, h = (bhc >> 1) & 7, c = bhc & 1;
            const attn_body::bf16* Q = PROJ + 3072 + h * 128 + c * 64; const attn_body::bf16* K = PROJ + 4096 + h * 128 + c * 64; const attn_body::bf16* V = PROJ + 5120 + h * 128;
            attn_body::bf16* O = OP + c * 1024 + h * 128;
            attn_body::attn_unit<8>(b, (ui & 1) ? 15 - s : s, Q, K, V, O, (char*)lds_raw);
        }
    }
    SEAM(3);
    if (IN(4)) {
        const float p1 = a.in[9][lane] * a.in[10][lane], p2 = a.in[11][lane] * a.in[12][lane];
        const float lam = expf(wave_sum(p1)) - expf(wave_sum(p2)) + 0.2f;
        combine_phase(a, gw, NGW, lane, lam);
    }
    SEAM(4);
    if (IN(5)) {
        pg8::Gemm g{(const bf16*)(ws + WS_CAT), (const bf16*)(ws + WS_WOUT0), MT, DMOD, DMOD}; pg8::StaticOrder S; S.init(MT, DMOD, G, bx);
        pg8::EpiResNorm E{(bf16*)(ws + WS_H), (float*)(ws + WS_SUMSQ)};
        pg8::gemm_phase<pg8::EpiResNorm, pg8::StaticOrder, PG8_ALIGN, PG8_SP2>(lds, g, S, E);
    }
    SEAM(5);
    if (IN(7)) {
        pg8::Gemm g{(const bf16*)(ws + WS_H), (const bf16*)(ws + WS_WIN1), MT, 4096, DMOD}; pg8::StaticOrder S; S.init(MT, 4096, G, bx);
        pg8::EpiUG E{(bf16*)(ws + WS_UGM), (bf16*)(ws + WS_GATE), MT, (const float*)(ws + WS_SUMSQ)};
        pg8::gemm_phase<pg8::EpiUG, pg8::StaticOrder, PG8_ALIGN, PG8_SP2>(lds, g, S, E);
    }
    if (IN(7) && IN(8)) {
        const int g = bx & 127; const int t7 = wave * 64 + (int)__builtin_amdgcn_mbcnt_hi(~0u, __builtin_amdgcn_mbcnt_lo(~0u, 0u)); unsigned acc = 0u;
        const unsigned* wf = (const unsigned*)(ws + WS_WF) + (size_t)g * 32768; const unsigned* vf = (const unsigned*)(ws + WS_VF) + (size_t)g * 32768; const unsigned* tf = (const unsigned*)(ws + WS_TF) + (size_t)g * 8192;
#pragma unroll
        for (int i = 0; i < 2; ++i) { acc ^= wf[(t7 + i * NTHR) * 32]; acc ^= vf[(t7 + i * NTHR) * 32]; }
        if (t7 < 256) acc ^= tf[t7 * 32];
        asm volatile("" :: "v"(acc));
    }
    SEAM(7);
    if (IN(8)) { s5_phase(a, lds, bx, G, tid, lane, wave); }
#if defined(TWICE_P) && TWICE_P == 8
    s5_phase(a, lds, bx, G, tid, lane, wave);
#endif
    SEAM(8);
    if (IN(9)) {
        pg8::Gemm g{(const bf16*)(ws + WS_Z), (const bf16*)(ws + WS_WGLU), MT, DMOD, DMOD}; pg8::StaticOrder S; S.init(MT, DMOD, G, bx);
        pg8::EpiGlu E{(const bf16*)(ws + WS_Z), (const bf16*)(ws + WS_GATE), (bf16*)(ws + WS_OUT2), a.in[26]};
        pg8::gemm_phase<pg8::EpiGlu, pg8::StaticOrder, PG8_ALIGN, PG8_SP2>(lds, g, S, E);
    }
    SEAM(9);
    if (IN(10)) {
        pg8::Gemm g{(const bf16*)(ws + WS_OUT2), (const bf16*)(ws + WS_WOUT1), MT, DMOD, DMOD}; pg8::StaticOrder S; S.init(MT, DMOD, G, bx);
        pg8::EpiResOut E{(const bf16*)(ws + WS_H), a.out};
        pg8::gemm_phase<pg8::EpiResOut, pg8::StaticOrder, PG8_ALIGN, PG8_SP2>(lds, g, S, E);
    }
#ifdef PROBE_XBAR
    for (int q = 0; q < PROBE_XBAR; ++q) xcd_barrier(bar);
#endif
#ifdef PROBE_A
    STAMP(11);
    xcd_barrier(bar);
    if (bx == 0) { const unsigned long long* ts = (const unsigned long long*)(ws + 32768);
        const float dA = (float)(ts[PROBE_A + 1] - ts[PROBE_A]) * 0.01f, dB = (float)(ts[PROBE_B + 1] - ts[PROBE_B]) * 0.01f;
        if (tid == 0) a.out[0] += dA;
        for (int i = tid; i < 4096; i += NTHR) a.out[4096 + i] += dB * 0.125f; }
#endif
#undef IN
#undef SEAM
}

extern "C" void kernel_launch(void* const* d_in, const int* in_sizes, int n_in, void* d_out, int out_size, void* d_ws, size_t ws_size, hipStream_t stream) {
    static int grid = 0;
    if (grid == 0) {
        if (n_in != 28 || in_sizes[0] != MT * DMOD || out_size != MT * DMOD || ws_size < WS_END) { fprintf(stderr, "kernel_launch: unexpected shapes (n_in %d, in0 %d, out %d, ws %zu)\n", n_in, n_in > 0 ? in_sizes[0] : -1, out_size, ws_size); grid = -1; return; }
        int dev = 0, cus = 0, per_cu = 0;
        if (hipGetDevice(&dev) != hipSuccess || hipDeviceGetAttribute(&cus, hipDeviceAttributeMultiprocessorCount, dev) != hipSuccess) { grid = -1; return; }
        if (hipFuncSetAttribute((const void*)fwd_kernel, hipFuncAttributeMaxDynamicSharedMemorySize, LDS_BYTES) != hipSuccess) { fprintf(stderr, "kernel_launch: hipFuncSetAttribute failed\n"); grid = -1; return; }
        if (hipOccupancyMaxActiveBlocksPerMultiprocessor(&per_cu, (const void*)fwd_kernel, NTHR, LDS_BYTES) != hipSuccess || per_cu < 1) { fprintf(stderr, "kernel_launch: occupancy query says %d blocks per CU\n", per_cu); (void)hipGetLastError(); grid = -1; return; }
        grid = cus;
    }
    if (grid < 0) return;
    if (hipMemsetAsync(d_ws, 0, WS_ZERO_BYTES, stream) != hipSuccess) { fprintf(stderr, "kernel_launch: memset failed\n"); return; }
    Args a{};
    for (int i = 0; i < 28; ++i) a.in[i] = (const float*)d_in[i];
    a.out = (float*)d_out; a.ws = (unsigned char*)d_ws;
    void* args[] = {&a};
    a.mask = -1;
#if defined(PROBE_LO)
    a.ph_lo = PROBE_LO; a.ph_hi = PROBE_HI; a.mask = PROBE_MASK;
    (void)hipLaunchCooperativeKernel((const void*)fwd_kernel, dim3(grid), dim3(NTHR), args, LDS_BYTES, stream);
    (void)hipMemsetAsync(d_ws, 0, WS_ZERO_BYTES, stream);
    a.mask = -1;
#endif
#if defined(PROBE_PREFIX)
    a.ph_lo = 0; a.ph_hi = PROBE_PREFIX;
    (void)hipLaunchCooperativeKernel((const void*)fwd_kernel, dim3(grid), dim3(NTHR), args, LDS_BYTES, stream);
    (void)hipMemsetAsync(d_ws, 0, WS_ZERO_BYTES, stream);
#endif
#if MK_N_LAUNCHES == 1
    a.ph_lo = 0; a.ph_hi = NPH;
    hipError_t e = hipLaunchCooperativeKernel((const void*)fwd_kernel, dim3(grid), dim3(NTHR), args, LDS_BYTES, stream);
    if (e != hipSuccess) fprintf(stderr, "kernel_launch: cooperative launch failed: %s (grid %d)\n", hipGetErrorString(e), grid);
#else
    for (int ph = 0; ph < NPH; ++ph) { a.ph_lo = ph; a.ph_hi = ph + 1;
        hipError_t e = hipLaunchCooperativeKernel((const void*)fwd_kernel, dim3(grid), dim3(NTHR), args, LDS_BYTES, stream);
        if (e != hipSuccess) { fprintf(stderr, "kernel_launch: cooperative launch %d failed: %s (grid %d)\n", ph, hipGetErrorString(e), grid); break; } }
#endif
}
```

```cpp
#include <hip/hip_runtime.h>
#include <hip/hip_cooperative_groups.h>
#include <hip/hip_bf16.h>
#include <cstdio>
#include <cstdint>
#include <cmath>
namespace cg = cooperative_groups;
namespace pg8 {
#define PG8_LAS __attribute__((address_space(3)))
typedef unsigned short bf16_t;
typedef short bf16x8 __attribute__((ext_vector_type(8)));
typedef float f32x4 __attribute__((ext_vector_type(4)));
typedef unsigned u32x4 __attribute__((ext_vector_type(4)));
constexpr int BM = 256, BK = 64, HALF = 128, HTB = HALF * BK * 2  , STAGE_BYTES = 8 * HTB, NXCD = 8, WGM = 8;

__host__ __device__ __forceinline__ int lds_byte(int r, int c) { const int st = (r >> 4) * 2 + (c >> 5), rr = r & 15, cc = c & 31, ob = rr * 64 + cc * 2; return st * 1024 + (ob ^ (((ob >> 9) & 1) << 5)); }
__host__ __device__ __forceinline__ void stage_rc(int b, int& R, int& C) { const int st = b / 1024, sb = b % 1024, swz = sb ^ (((sb >> 9) & 1) << 5); R = (st >> 1) * 16 + swz / 64; C = (st & 1) * 32 + (swz % 64) / 2; }
__host__ __device__ __forceinline__ int perm32(int rho) { const int n = rho >> 4, i = rho & 15; return 8 * (i >> 2) + 4 * n + (i & 3); }

struct Unit { int pm, pn; };
struct Gemm { const bf16_t* A; const bf16_t* Bt; int M, N, K; };

struct StaticOrder {
    int nM, nN, nwg, G, c;
    __host__ __device__ void init(int M, int N, int G_, int c_) { nM = M / BM; nN = N / BM; nwg = nM * nN; G = G_; c = c_; }
    __host__ __device__ bool next(int i, Unit& u) const {
        const long L = (long)i * G + c; if (L >= nwg) return false;
        int wgid = (int)L; { const int q = nwg / NXCD, r = nwg % NXCD, xcd = wgid % NXCD, off = wgid / NXCD; wgid = (xcd < r ? xcd * (q + 1) : r * (q + 1) + (xcd - r) * q) + off; }
        const int nig = WGM * nN, gid = wgid / nig, fm = gid * WGM, gsz = (nM - fm) < WGM ? (nM - fm) : WGM;
        u.pm = fm + ((wgid % nig) % gsz); u.pn = (wgid % nig) / gsz; return true;
    }
    __device__ __forceinline__ void a_ready(const Unit&) const {}
    __device__ __forceinline__ void done(const Unit&) const {}
};

__device__ __forceinline__ unsigned cvt_pk_bf16(float lo, float hi) { unsigned r; asm volatile("v_cvt_pk_bf16_f32 %0, %1, %2" : "=v"(r) : "v"(lo), "v"(hi)); return r; }
typedef float f32x2 __attribute__((ext_vector_type(2)));
__device__ __forceinline__ f32x2 gelu_pk(f32x2 v) {
    const f32x2 av = __builtin_elementwise_abs(v), d = av * 0.2316418882f + 1.0f;
    f32x2 t; t.x = __builtin_amdgcn_rcpf(d.x); t.y = __builtin_amdgcn_rcpf(d.y);
    f32x2 q = t * 0.5307027145f + (-0.7265760135f); q = q * t + 0.7107068705f; q = q * t + (-0.142248368f); q = q * t + 0.127414796f; q = q * t;
    const f32x2 s = (v * v) * (-0.72134752044f);
    f32x2 e; e.x = __builtin_amdgcn_exp2f(s.x); e.y = __builtin_amdgcn_exp2f(s.y);
    const f32x2 m = v * (q * e), r = v - m;
    f32x2 o; o.x = v.x < 0.f ? m.x : r.x; o.y = v.y < 0.f ? m.y : r.y; return o;
}

template <int ACT  > struct EpiBf16 {
    static constexpr bool PERM = true, AFTER_DRAIN = false; static_assert(ACT == 0 || ACT == 1, "EpiBf16: ACT is 0 (none) or 1 (gelu_pk)");
    bf16_t* O; int ldc; const float* bias; int split_cols; size_t split_stride; float scale0;
    __device__ __forceinline__ void operator()(const f32x4 (&acc)[2][2][4][2], const Unit& u, int wr, int wc, int fr, int fq) const {
        const int row0 = u.pm * BM + wr * 64 + fr; int colt = u.pn * BM; bf16_t* base = O;
        float sc = 1.f; if (split_cols) { const int t = colt / split_cols; base += (size_t)t * split_stride; colt -= t * split_cols; if (t == 0) sc = scale0; }
        const int col0 = colt + wc * 32 + 8 * fq, bcol0 = u.pn * BM + wc * 32 + 8 * fq;
        f32x4 bv[2][2];
#pragma unroll
        for (int bj = 0; bj < 2; ++bj)
#pragma unroll
            for (int n = 0; n < 2; ++n) bv[bj][n] = bias ? *(const f32x4*)(bias + bcol0 + bj * HALF + 4 * n) : (f32x4){0.f, 0.f, 0.f, 0.f};
#pragma unroll
        for (int ai = 0; ai < 2; ++ai)
#pragma unroll
            for (int m = 0; m < 4; ++m) { bf16_t* rowp = base + (size_t)(row0 + ai * HALF + m * 16) * ldc + col0;
#pragma unroll
                for (int bj = 0; bj < 2; ++bj) { f32x4 v0 = acc[ai][bj][m][0] + bv[bj][0], v1 = acc[ai][bj][m][1] + bv[bj][1];
                    if (ACT == 1) { f32x2 a = gelu_pk((f32x2){v0[0], v0[1]}), b = gelu_pk((f32x2){v0[2], v0[3]}), c = gelu_pk((f32x2){v1[0], v1[1]}), d = gelu_pk((f32x2){v1[2], v1[3]});
                        v0 = (f32x4){a.x, a.y, b.x, b.y}; v1 = (f32x4){c.x, c.y, d.x, d.y}; }
                    v0 = v0 * sc; v1 = v1 * sc; u32x4 w; w.x = cvt_pk_bf16(v0[0], v0[1]); w.y = cvt_pk_bf16(v0[2], v0[3]); w.z = cvt_pk_bf16(v1[0], v1[1]); w.w = cvt_pk_bf16(v1[2], v1[3]);
                    *(u32x4*)(rowp + bj * HALF) = w; } }
    }
};
__device__ __forceinline__ float bflo(unsigned u) { return __uint_as_float(u << 16); }
__device__ __forceinline__ float bfhi(unsigned u) { return __uint_as_float(u & 0xffff0000u); }
__device__ __forceinline__ float sigm(float x) { return __builtin_amdgcn_rcpf(1.0f + __expf(-x)); }
struct EpiBf16Row {
    static constexpr bool PERM = true, AFTER_DRAIN = false;
    bf16_t* O; int ldc; const float* rs;
    __device__ __forceinline__ void operator()(const f32x4 (&acc)[2][2][4][2], const Unit& u, int wr, int wc, int fr, int fq) const {
        const int row0 = u.pm * BM + wr * 64 + fr, col0 = u.pn * BM + wc * 32 + 8 * fq;
        const bool silu_tile = (u.pn >= 8 && u.pn < 12) || u.pn >= 24;
        if (u.pn < 8) {
#pragma unroll
            for (int ai = 0; ai < 2; ++ai)
#pragma unroll
                for (int m = 0; m < 4; ++m) { const int row = row0 + ai * HALF + m * 16; const float sc = rs[row];
                    const f32x4 v0 = acc[ai][0][m][0] * sc, v1 = acc[ai][0][m][1] * sc, g0 = acc[ai][1][m][0] * sc, g1 = acc[ai][1][m][1] * sc;
                    u32x4 w; w.x = cvt_pk_bf16(v0[0] * sigm(g0[0]), v0[1] * sigm(g0[1])); w.y = cvt_pk_bf16(v0[2] * sigm(g0[2]), v0[3] * sigm(g0[3]));
                    w.z = cvt_pk_bf16(v1[0] * sigm(g1[0]), v1[1] * sigm(g1[1])); w.w = cvt_pk_bf16(v1[2] * sigm(g1[2]), v1[3] * sigm(g1[3]));
                    *(u32x4*)(O + (size_t)row * ldc + u.pn * 128 + wc * 32 + 8 * fq) = w; }
            return; }
#pragma unroll
        for (int ai = 0; ai < 2; ++ai)
#pragma unroll
            for (int m = 0; m < 4; ++m) { const int row = row0 + ai * HALF + m * 16; const float sc = rs[row]; bf16_t* rowp = O + (size_t)row * ldc + col0;
#pragma unroll
                for (int bj = 0; bj < 2; ++bj) { f32x4 v0 = acc[ai][bj][m][0] * sc, v1 = acc[ai][bj][m][1] * sc;
                    if (silu_tile) {
#pragma unroll
                        for (int e = 0; e < 4; ++e) { v0[e] *= sigm(v0[e]); v1[e] *= sigm(v1[e]); } }
                    u32x4 w; w.x = cvt_pk_bf16(v0[0], v0[1]); w.y = cvt_pk_bf16(v0[2], v0[3]); w.z = cvt_pk_bf16(v1[0], v1[1]); w.w = cvt_pk_bf16(v1[2], v1[3]);
                    *(u32x4*)(rowp + bj * HALF) = w; } }
    }
};
struct EpiResF32 {
    static constexpr bool PERM = false, AFTER_DRAIN = false;
    const float* base; float* out; int ldc;
    __device__ __forceinline__ void operator()(const f32x4 (&acc)[2][2][4][2], const Unit& u, int wr, int wc, int fr, int fq) const {
        const int row0 = u.pm * BM + wr * 64 + fr, col0 = u.pn * BM + wc * 32 + 4 * fq;
#pragma unroll
        for (int ai = 0; ai < 2; ++ai)
#pragma unroll
            for (int m = 0; m < 4; ++m) { const size_t off = (size_t)(row0 + ai * HALF + m * 16) * ldc + col0;
#pragma unroll
                for (int bj = 0; bj < 2; ++bj)
#pragma unroll
                    for (int n = 0; n < 2; ++n) { const f32x4 b = *(const f32x4*)(base + off + bj * HALF + n * 16); *(f32x4*)(out + off + bj * HALF + n * 16) = b + acc[ai][bj][m][n]; } }
    }
};
struct EpiResNorm {
    static constexpr bool PERM = true, AFTER_DRAIN = false;
    bf16_t* X; float* sumsq;
    __device__ __forceinline__ void operator()(const f32x4 (&acc)[2][2][4][2], const Unit& u, int wr, int wc, int fr, int fq) const {
        const int row0 = u.pm * BM + wr * 64 + fr, colb = u.pn * BM + wc * 32 + 8 * fq;
#pragma unroll
        for (int ai = 0; ai < 2; ++ai) {
            u32x4 xb[4][2];
#pragma unroll
            for (int m = 0; m < 4; ++m)
#pragma unroll
                for (int bj = 0; bj < 2; ++bj) xb[m][bj] = *(const u32x4*)(X + (size_t)(row0 + ai * HALF + m * 16) * 2048 + colb + bj * HALF);
#pragma unroll
            for (int m = 0; m < 4; ++m) { const int row = row0 + ai * HALF + m * 16; const size_t off = (size_t)row * 2048 + colb; float ss = 0.f;
#pragma unroll
                for (int bj = 0; bj < 2; ++bj) { const u32x4 xv = xb[m][bj];
                    const f32x4 x0 = (f32x4){bflo(xv.x), bfhi(xv.x), bflo(xv.y), bfhi(xv.y)} + acc[ai][bj][m][0], x1 = (f32x4){bflo(xv.z), bfhi(xv.z), bflo(xv.w), bfhi(xv.w)} + acc[ai][bj][m][1];
                    ss += (x0[0] * x0[0] + x0[1] * x0[1]) + (x0[2] * x0[2] + x0[3] * x0[3]) + (x1[0] * x1[0] + x1[1] * x1[1]) + (x1[2] * x1[2] + x1[3] * x1[3]);
                    u32x4 w; w.x = cvt_pk_bf16(x0[0], x0[1]); w.y = cvt_pk_bf16(x0[2], x0[3]); w.z = cvt_pk_bf16(x1[0], x1[1]); w.w = cvt_pk_bf16(x1[2], x1[3]);
                    *(u32x4*)(X + off + bj * HALF) = w; }
                ss += __shfl_xor(ss, 16); ss += __shfl_xor(ss, 32);
                if (fq == 0) (void)__hip_atomic_fetch_add(sumsq + row, ss, __ATOMIC_RELAXED, __HIP_MEMORY_SCOPE_AGENT); } }
    }
};
struct EpiResOut {
    static constexpr bool PERM = true, AFTER_DRAIN = false;
    const bf16_t* base; float* out;
    __device__ __forceinline__ void operator()(const f32x4 (&acc)[2][2][4][2], const Unit& u, int wr, int wc, int fr, int fq) const {
        const int row0 = u.pm * BM + wr * 64 + fr, colb = u.pn * BM + wc * 32 + 8 * fq;
#pragma unroll
        for (int ai = 0; ai < 2; ++ai) {
            u32x4 xb[4][2];
#pragma unroll
            for (int m = 0; m < 4; ++m)
#pragma unroll
                for (int bj = 0; bj < 2; ++bj) xb[m][bj] = *(const u32x4*)(base + (size_t)(row0 + ai * HALF + m * 16) * 2048 + colb + bj * HALF);
#pragma unroll
            for (int m = 0; m < 4; ++m) { const size_t off = (size_t)(row0 + ai * HALF + m * 16) * 2048 + colb;
#pragma unroll
                for (int bj = 0; bj < 2; ++bj) { const u32x4 xv = xb[m][bj];
                    *(f32x4*)(out + off + bj * HALF) = (f32x4){bflo(xv.x), bfhi(xv.x), bflo(xv.y), bfhi(xv.y)} + acc[ai][bj][m][0];
                    *(f32x4*)(out + off + bj * HALF + 4) = (f32x4){bflo(xv.z), bfhi(xv.z), bflo(xv.w), bfhi(xv.w)} + acc[ai][bj][m][1]; } } }
    }
};
struct EpiUG {
    static constexpr bool PERM = true, AFTER_DRAIN = false;
    bf16_t* Ugm; bf16_t* Gate; int mrows; const float* sumsq;
    __device__ __forceinline__ void operator()(const f32x4 (&acc)[2][2][4][2], const Unit& u, int wr, int wc, int fr, int fq) const {
        const int row0 = u.pm * BM + wr * 64 + fr, colb = u.pn * BM + wc * 32 + 8 * fq;
#pragma unroll
        for (int ai = 0; ai < 2; ++ai)
#pragma unroll
            for (int m = 0; m < 4; ++m) { const int row = row0 + ai * HALF + m * 16; const float rs = 1.0f / sqrtf(sumsq[row] * (1.0f / 2048.0f) + 1e-6f);
#pragma unroll
                for (int bj = 0; bj < 2; ++bj) { const int col = colb + bj * HALF; const f32x4 v0 = acc[ai][bj][m][0] * rs, v1 = acc[ai][bj][m][1] * rs;
                    u32x4 w; w.x = cvt_pk_bf16(v0[0], v0[1]); w.y = cvt_pk_bf16(v0[2], v0[3]); w.z = cvt_pk_bf16(v1[0], v1[1]); w.w = cvt_pk_bf16(v1[2], v1[3]);
                    if (col < 2048) *(u32x4*)(Ugm + ((size_t)(col >> 4) * mrows + row) * 16 + (col & 8)) = w;
                    else *(u32x4*)(Gate + (size_t)row * 2048 + (col - 2048)) = w; } }
    }
};
struct EpiGlu {
    static constexpr bool PERM = true, AFTER_DRAIN = false;
    const bf16_t* Z; const bf16_t* Gate; bf16_t* O; const float* bias;
    __device__ __forceinline__ void operator()(const f32x4 (&acc)[2][2][4][2], const Unit& u, int wr, int wc, int fr, int fq) const {
        const int row0 = u.pm * BM + wr * 64 + fr, colb = u.pn * BM + wc * 32 + 8 * fq;
        f32x4 bv[2][2];
#pragma unroll
        for (int bj = 0; bj < 2; ++bj)
#pragma unroll
            for (int n = 0; n < 2; ++n) bv[bj][n] = *(const f32x4*)(bias + colb + bj * HALF + 4 * n);
#pragma unroll
        for (int ai = 0; ai < 2; ++ai)
#pragma unroll
            for (int m = 0; m < 4; ++m) { const size_t roff = (size_t)(row0 + ai * HALF + m * 16) * 2048 + colb;
#pragma unroll
                for (int bj = 0; bj < 2; ++bj) { const f32x4 v0 = acc[ai][bj][m][0] + bv[bj][0], v1 = acc[ai][bj][m][1] + bv[bj][1];
                    const u32x4 zz = *(const u32x4*)(Z + roff + bj * HALF), gg = *(const u32x4*)(Gate + roff + bj * HALF);
                    float o[8]; const float a[8] = {v0[0], v0[1], v0[2], v0[3], v1[0], v1[1], v1[2], v1[3]};
#pragma unroll
                    for (int q = 0; q < 4; ++q) { const unsigned zw = zz[q], gw = gg[q]; const float z0 = bflo(zw), z1 = bfhi(zw), g0 = bflo(gw), g1 = bfhi(gw);
                        o[2 * q] = z0 * sigm(a[2 * q]) * (g0 * sigm(g0)); o[2 * q + 1] = z1 * sigm(a[2 * q + 1]) * (g1 * sigm(g1)); }
                    u32x4 w; w.x = cvt_pk_bf16(o[0], o[1]); w.y = cvt_pk_bf16(o[2], o[3]); w.z = cvt_pk_bf16(o[4], o[5]); w.w = cvt_pk_bf16(o[6], o[7]);
                    *(u32x4*)(O + roff + bj * HALF) = w; } }
    }
};

template <class Epi, class Sched, bool ALIGN_EPI = false, bool SP2 = false>
__device__ __forceinline__ void gemm_phase(PG8_LAS unsigned char* lds, const Gemm g, const Sched& S, const Epi& E) {
    const int tid = threadIdx.x, wid = __builtin_amdgcn_readfirstlane(tid >> 6), lane = tid & 63, wr = wid >> 2, wc = wid & 3, fr = lane & 15, fq = lane >> 4;
    const int K = g.K, nt = K / BK;
    unsigned voffA[2], voffB[2];
#pragma unroll
    for (int i = 0; i < 2; ++i) { int R, C; stage_rc(tid * 16 + i * 8192, R, C); const int Rb = Epi::PERM ? ((R & ~31) + perm32(R & 31)) : R;
        voffA[i] = (unsigned)(R * K + C) * 2u; voffB[i] = (unsigned)(Rb * K + C) * 2u; }
    const size_t kstep = (size_t)(BK * 2);
    const size_t hstep = (size_t)HALF * K * 2;
    const size_t tstep = 2 * hstep;
    const unsigned ldsw = (unsigned)wid * 1024u;
    const int aoff = lds_byte(wr * 64 + fr, fq * 8), boff = lds_byte(wc * 32 + fr, fq * 8);
#define PG8_SA(b, h) (((b) * 2 + (h)) * HTB)
#define PG8_SB(b, h) ((4 + (b) * 2 + (h)) * HTB)
#define PG8_STAGE(bufoff, gbase, voff) do { _Pragma("unroll") for (int _i = 0; _i < 2; ++_i) \
        __builtin_amdgcn_global_load_lds((const unsigned*)((const char*)(gbase) + (voff)[_i]), (PG8_LAS unsigned*)(lds + (bufoff) + ldsw + _i * 8192), 16, 0, 0); } while (0)
#define PG8_LDA(dst, b, h) do { _Pragma("unroll") for (int m = 0; m < 4; ++m) _Pragma("unroll") for (int k = 0; k < 2; ++k) dst[m][k] = *(const PG8_LAS bf16x8*)(lds + PG8_SA(b, h) + aoff + m * 2048 + k * 1024); } while (0)
#define PG8_LDB(dst, b, h) do { _Pragma("unroll") for (int n = 0; n < 2; ++n) _Pragma("unroll") for (int k = 0; k < 2; ++k) dst[n][k] = *(const PG8_LAS bf16x8*)(lds + PG8_SB(b, h) + boff + n * 2048 + k * 1024); } while (0)
#define PG8_MMA(ai, bj, At, Bt) do { __builtin_amdgcn_s_setprio(1); _Pragma("unroll") for (int m = 0; m < 4; ++m) _Pragma("unroll") for (int n = 0; n < 2; ++n) _Pragma("unroll") for (int k = 0; k < 2; ++k) \
        acc[ai][bj][m][n] = __builtin_amdgcn_mfma_f32_16x16x32_bf16(Bt[n][k], At[m][k], acc[ai][bj][m][n], 0, 0, 0); __builtin_amdgcn_s_setprio(0); } while (0)
#define PG8_WAIT_V(n) asm volatile("s_waitcnt vmcnt(" #n ")" ::: "memory")
#define PG8_WAIT_L(n) asm volatile("s_waitcnt lgkmcnt(" #n ")" ::: "memory")
#define PG8_BAR __builtin_amdgcn_s_barrier()
#define PG8_SCHED __builtin_amdgcn_sched_barrier(0)
    Unit cur, nxt; int ui = 0;
    if (!S.next(0, cur)) return;
    f32x4 acc[2][2][4][2];
#pragma unroll
    for (int a = 0; a < 2; ++a)
#pragma unroll
        for (int b = 0; b < 2; ++b)
#pragma unroll
            for (int m = 0; m < 4; ++m)
#pragma unroll
                for (int n = 0; n < 2; ++n) acc[a][b][m][n] = (f32x4){0.f, 0.f, 0.f, 0.f};
    bf16x8 At[4][2], B0[2][2], B1[2][2];
    const char* cA = (const char*)g.A + (size_t)cur.pm * tstep; const char* cB = (const char*)g.Bt + (size_t)cur.pn * tstep;
    S.a_ready(cur);
    if constexpr (SP2) {
        PG8_STAGE(PG8_SB(0, 0), cB, voffB); PG8_STAGE(PG8_SB(0, 1), cB + hstep, voffB); PG8_STAGE(PG8_SA(0, 0), cA, voffA); PG8_STAGE(PG8_SA(0, 1), cA + hstep, voffA);
        if (wr == 1) PG8_BAR;
        PG8_WAIT_V(2); PG8_BAR;
        PG8_STAGE(PG8_SB(1, 0), cB + kstep, voffB); PG8_STAGE(PG8_SA(1, 0), cA + kstep, voffA); PG8_STAGE(PG8_SB(1, 1), cB + hstep + kstep, voffB);
        PG8_WAIT_V(6); PG8_BAR;
    } else {
        PG8_STAGE(PG8_SB(0, 0), cB, voffB); PG8_STAGE(PG8_SA(0, 0), cA, voffA); PG8_STAGE(PG8_SB(0, 1), cB + hstep, voffB); PG8_STAGE(PG8_SA(0, 1), cA + hstep, voffA);
        if (wr == 1) PG8_BAR;
        PG8_WAIT_V(4); PG8_BAR;
        PG8_STAGE(PG8_SB(1, 0), cB + kstep, voffB); PG8_STAGE(PG8_SA(1, 0), cA + kstep, voffA); PG8_STAGE(PG8_SB(1, 1), cB + hstep + kstep, voffB);
        PG8_WAIT_V(6); PG8_BAR;
    }
    for (;;) {
        const bool has_next = S.next(ui + 1, nxt);
        const char* nA = has_next ? (const char*)g.A + (size_t)nxt.pm * tstep : cA; const char* nB = has_next ? (const char*)g.Bt + (size_t)nxt.pn * tstep : cB;
        for (int t = 0; t < nt; t += 2) {
            const bool last = (t == nt - 2);
            const char* a1 = cA + (size_t)(t + 1) * kstep;
            const char* a2 = last ? nA : cA + (size_t)(t + 2) * kstep; const char* b2 = last ? nB : cB + (size_t)(t + 2) * kstep;
            const char* a3 = a2 + kstep; const char* b3 = b2 + kstep;
            if (last && has_next) S.a_ready(nxt);
            if constexpr (SP2) {
            PG8_LDB(B0, 0, 0); PG8_LDB(B1, 0, 1); PG8_SCHED; PG8_LDA(At, 0, 0); PG8_STAGE(PG8_SA(1, 1), a1 + hstep, voffA);
            PG8_WAIT_V(8); PG8_WAIT_L(0); PG8_BAR; PG8_MMA(0, 0, At, B0); PG8_MMA(0, 1, At, B1); PG8_BAR; PG8_SCHED;
            PG8_LDA(At, 0, 1); PG8_STAGE(PG8_SB(0, 0), b2, voffB); PG8_STAGE(PG8_SB(0, 1), b2 + hstep, voffB); PG8_STAGE(PG8_SA(0, 0), a2, voffA);
            PG8_WAIT_V(8); PG8_WAIT_L(0); PG8_BAR; PG8_MMA(1, 0, At, B0); PG8_MMA(1, 1, At, B1); PG8_BAR; PG8_SCHED;
            PG8_LDB(B0, 1, 0); PG8_LDB(B1, 1, 1); PG8_SCHED; PG8_LDA(At, 1, 0); PG8_STAGE(PG8_SA(0, 1), a2 + hstep, voffA);
            PG8_WAIT_V(8); PG8_WAIT_L(0); PG8_BAR; PG8_MMA(0, 0, At, B0); PG8_MMA(0, 1, At, B1); PG8_BAR; PG8_SCHED;
            PG8_LDA(At, 1, 1); PG8_STAGE(PG8_SB(1, 0), b3, voffB); PG8_STAGE(PG8_SB(1, 1), b3 + hstep, voffB); PG8_STAGE(PG8_SA(1, 0), a3, voffA);
            PG8_WAIT_V(8); PG8_WAIT_L(0); PG8_BAR; PG8_MMA(1, 0, At, B0); PG8_MMA(1, 1, At, B1); PG8_BAR; PG8_SCHED;
            } else {
            PG8_LDB(B0, 0, 0); PG8_SCHED; PG8_LDA(At, 0, 0); PG8_STAGE(PG8_SA(1, 1), a1 + hstep, voffA);
            PG8_WAIT_L(8); PG8_BAR; PG8_WAIT_L(0); PG8_MMA(0, 0, At, B0); PG8_BAR; PG8_SCHED;
            PG8_LDB(B1, 0, 1); PG8_STAGE(PG8_SB(0, 0), b2, voffB);
            PG8_BAR; PG8_WAIT_L(0); PG8_MMA(0, 1, At, B1); PG8_BAR;
            PG8_LDA(At, 0, 1); PG8_STAGE(PG8_SA(0, 0), a2, voffA);
            PG8_BAR; PG8_WAIT_L(0); PG8_MMA(1, 0, At, B0); PG8_BAR; PG8_SCHED;
            PG8_STAGE(PG8_SB(0, 1), b2 + hstep, voffB);
            PG8_WAIT_V(6); PG8_BAR; PG8_MMA(1, 1, At, B1); PG8_BAR;
            PG8_LDB(B0, 1, 0); PG8_SCHED; PG8_LDA(At, 1, 0); PG8_STAGE(PG8_SA(0, 1), a2 + hstep, voffA);
            PG8_WAIT_L(8); PG8_BAR; PG8_WAIT_L(0); PG8_MMA(0, 0, At, B0); PG8_BAR; PG8_SCHED;
            PG8_LDB(B1, 1, 1); PG8_STAGE(PG8_SB(1, 0), b3, voffB);
            PG8_BAR; PG8_WAIT_L(0); PG8_MMA(0, 1, At, B1); PG8_BAR;
            PG8_LDA(At, 1, 1); PG8_STAGE(PG8_SA(1, 0), a3, voffA);
            PG8_BAR; PG8_WAIT_L(0); PG8_MMA(1, 0, At, B0); PG8_BAR; PG8_SCHED;
            PG8_STAGE(PG8_SB(1, 1), b3 + hstep, voffB);
            PG8_WAIT_V(6); PG8_BAR; PG8_MMA(1, 1, At, B1); PG8_BAR;
            }
        }
        if constexpr (ALIGN_EPI) { if (wr == 0) PG8_BAR; }
        if constexpr (!Epi::AFTER_DRAIN) { E(acc, cur, wr, wc, fr, fq); S.done(cur); }
        if (!has_next) break;
#pragma unroll
        for (int a = 0; a < 2; ++a)
#pragma unroll
            for (int b = 0; b < 2; ++b)
#pragma unroll
                for (int m = 0; m < 4; ++m)
#pragma unroll
                    for (int n = 0; n < 2; ++n) acc[a][b][m][n] = (f32x4){0.f, 0.f, 0.f, 0.f};
        cur = nxt; cA = nA; cB = nB; ++ui;
        if constexpr (ALIGN_EPI) { if (wr == 1) PG8_BAR; }
    }
    PG8_WAIT_V(0);
    if constexpr (!ALIGN_EPI) { if (wr == 0) PG8_BAR; }
    PG8_BAR;
    if constexpr (Epi::AFTER_DRAIN) { E.fused(acc, cur, wr, wc, fr, fq, lds, wid, lane); S.done(cur); }
#undef PG8_SA
#undef PG8_SB
#undef PG8_STAGE
#undef PG8_LDA
#undef PG8_LDB
#undef PG8_MMA
#undef PG8_WAIT_V
#undef PG8_WAIT_L
#undef PG8_BAR
#undef PG8_SCHED
}
}

#ifndef PG8_SP2
#define PG8_SP2 true
#endif
#ifndef PG8_ALIGN
#define PG8_ALIGN true
#endif
namespace attn_body {
using bf16=__hip_bfloat16;
using bf16x8=__attribute__((ext_vector_type(8)))short;
using s16x4=__attribute__((ext_vector_type(4)))short;
using f32x16=__attribute__((ext_vector_type(16)))float;
using u32x4=__attribute__((ext_vector_type(4)))unsigned;
constexpr int SEQ=4096,D=64,DM=7168,OPITCH=7168;
constexpr int NW=8,QBLK=32,QB=QBLK*NW,KVBLK=64,NQB=SEQ/QB;
constexpr int ATTN_PITCH=DM, ATTN_UNIT_ROWS=QB;
__device__ __forceinline__ int crow(int r,int hi){return (r&3)+8*(r>>2)+4*hi;}
#define SBAR() __builtin_amdgcn_sched_barrier(0)
__device__ __forceinline__ void cmask(f32x16&p0,f32x16&p1,int jb,int qrel,int hi){
  const float NEG=-INFINITY; int kb=64*jb+4*hi;
  #pragma unroll
  for(int r=0;r<16;++r){int kv=kb+(r&3)+8*(r>>2); if(kv>qrel)p0[r]=NEG; if(kv+32>qrel)p1[r]=NEG;}
}

constexpr int NSLOT=3, SLOTB=8192;
constexpr int VSLOTB=2*SLOTB;
constexpr int LDS_K=0, LDS_V=NSLOT*SLOTB, LDS_WS=LDS_V+NSLOT*VSLOTB, LDS_OST=LDS_WS+NW*64*4, LDS_BYTES=LDS_OST+NW*8192;
constexpr float C2=0.125f*1.4426950408889634f;
__device__ __forceinline__ void glds16(const void*gsrc,unsigned lds_dst){unsigned keep;
  asm volatile("s_mov_b32 %0, m0\n\ts_mov_b32 m0, %2\n\ts_nop 0\n\tglobal_load_lds_dwordx4 %1, off\n\ts_mov_b32 m0, %0":"=&s"(keep):"v"(gsrc),"s"(lds_dst):"memory");}
__device__ __forceinline__ float max3f(float a,float b,float c){float r;asm("v_max3_f32 %0, %1, %2, %3":"=v"(r):"v"(a),"v"(b),"v"(c));return r;}
__device__ __forceinline__ float max2f(float a,float b){float r;asm("v_max_f32_e32 %0, %1, %2":"=v"(r):"v"(a),"v"(b));return r;}
__device__ __forceinline__ float fadd_s(float a,float b){float r;asm("v_add_f32_e32 %0, %1, %2":"=v"(r):"v"(a),"v"(b));return r;}
__device__ __forceinline__ float fsub_s(float a,float b){float r;asm("v_sub_f32_e32 %0, %1, %2":"=v"(r):"v"(a),"v"(b));return r;}
typedef float f32x2_t __attribute__((ext_vector_type(2))); typedef __bf16 bf16x2_t __attribute__((ext_vector_type(2)));
__device__ __forceinline__ unsigned cvtpk_s(float lo,float hi){f32x2_t v={lo,hi};bf16x2_t b=__builtin_convertvector(v,bf16x2_t);return __builtin_bit_cast(unsigned,b);}
#define WAIT_BAR(N) asm volatile("s_waitcnt vmcnt(" #N ") lgkmcnt(0)\n\ts_barrier":::"memory")

__device__ __forceinline__ void qkt(f32x16&p0,f32x16&p1,const char*Kslot,const bf16x8*qr,int r32,int hi){
  const char*kb=Kslot+hi*1024+r32*16;
  #pragma unroll
  for(int d0=0;d0<4;++d0){
    const bf16x8 b0=*reinterpret_cast<const bf16x8*>(kb+d0*2048);
    const bf16x8 b1=*reinterpret_cast<const bf16x8*>(kb+d0*2048+512);
    if(d0==0){p0=__builtin_amdgcn_mfma_f32_32x32x16_bf16(b0,qr[0],f32x16{},0,0,0);p1=__builtin_amdgcn_mfma_f32_32x32x16_bf16(b1,qr[0],f32x16{},0,0,0);}
    else{p0=__builtin_amdgcn_mfma_f32_32x32x16_bf16(b0,qr[d0],p0,0,0,0);p1=__builtin_amdgcn_mfma_f32_32x32x16_bf16(b1,qr[d0],p1,0,0,0);}}
}
typedef __attribute__((address_space(3))) const char* lds_cptr;
typedef short v4i16_t __attribute__((ext_vector_type(4)));
__device__ __forceinline__ void kload8(bf16x8*kf,lds_cptr kp){
  kf[0]=*(const __attribute__((address_space(3))) bf16x8*)(kp);      kf[1]=*(const __attribute__((address_space(3))) bf16x8*)(kp+512);
  kf[2]=*(const __attribute__((address_space(3))) bf16x8*)(kp+2048); kf[3]=*(const __attribute__((address_space(3))) bf16x8*)(kp+2560);
  kf[4]=*(const __attribute__((address_space(3))) bf16x8*)(kp+4096); kf[5]=*(const __attribute__((address_space(3))) bf16x8*)(kp+4608);
  kf[6]=*(const __attribute__((address_space(3))) bf16x8*)(kp+6144); kf[7]=*(const __attribute__((address_space(3))) bf16x8*)(kp+6656);
}
__device__ __forceinline__ void kload2(bf16x8*kf,lds_cptr kp,int j){ kf[2*j]=*(const __attribute__((address_space(3))) bf16x8*)(kp+j*2048); kf[2*j+1]=*(const __attribute__((address_space(3))) bf16x8*)(kp+j*2048+512); }
__device__ __forceinline__ s16x4 vtr(lds_cptr p){ return __builtin_bit_cast(s16x4,__builtin_amdgcn_ds_read_tr16_b64_v4i16((__attribute__((address_space(3))) v4i16_t*)p)); }
__device__ __forceinline__ float rowmax(const f32x16&p0,const f32x16&p1){
  float a=max3f(p0[0],p0[1],p1[0]),b=max3f(p0[2],p0[3],p1[1]);a=max3f(a,p1[2],p1[3]);
  #pragma unroll
  for(int r=4;r<16;r+=4){a=max3f(a,p0[r],p0[r+1]);b=max3f(b,p0[r+2],p0[r+3]);a=max3f(a,p1[r],p1[r+1]);b=max3f(b,p1[r+2],p1[r+3]);}
  const float m=max2f(a,b);
  auto rr=__builtin_amdgcn_permlane32_swap(__float_as_uint(m),__float_as_uint(m),false,false);
  return max2f(__uint_as_float(rr[0]),__uint_as_float(rr[1]));
}
__device__ __forceinline__ void pv(f32x16*o,int vb,bf16x8 pa0,bf16x8 pa1,bf16x8 pa2,bf16x8 pa3){
  #pragma unroll
  for(int d0=0;d0<4;++d0){s16x4 lo[4],hi[4];
    #pragma unroll
    for(int ks=0;ks<4;++ks){
      asm volatile("ds_read_b64_tr_b16 %0,%1 offset:%c2":"=&v"(lo[ks]):"v"(vb),"i"(d0*4096+ks*1024):"memory");
      asm volatile("ds_read_b64_tr_b16 %0,%1 offset:%c2":"=&v"(hi[ks]):"v"(vb),"i"(d0*4096+ks*1024+512):"memory");}
    asm volatile("s_waitcnt lgkmcnt(0)":::"memory");SBAR();
    #define PK(k) (bf16x8){lo[k][0],lo[k][1],lo[k][2],lo[k][3],hi[k][0],hi[k][1],hi[k][2],hi[k][3]}
    o[d0]=__builtin_amdgcn_mfma_f32_32x32x16_bf16(pa0,PK(0),o[d0],0,0,0);
    o[d0]=__builtin_amdgcn_mfma_f32_32x32x16_bf16(pa1,PK(1),o[d0],0,0,0);
    o[d0]=__builtin_amdgcn_mfma_f32_32x32x16_bf16(pa2,PK(2),o[d0],0,0,0);
    o[d0]=__builtin_amdgcn_mfma_f32_32x32x16_bf16(pa3,PK(3),o[d0],0,0,0);
    #undef PK
  }
}

#ifndef ATTN_STORE16
#define ATTN_STORE16(p,v) (*(u32x4*)(p)=(v))
#endif
template<int THRL> __device__ __forceinline__ void attn_unit(int b,int qb,const bf16*Q,const bf16*K,const bf16*V,bf16*O,char*shm,const bool pre,const bool nxt){
  const int tid=threadIdx.x,lane=tid&63,r32=lane&31,hi=lane>>5; const int wid=__builtin_amdgcn_readfirstlane(tid>>6);
  const long rowbase=(long)b*SEQ; const int q0=qb*QB;
  const bf16*Qw=Q+(rowbase+q0+wid*QBLK)*DM;
  const bf16*Kh=K+rowbase*DM,*Vh=V+rowbase*DM;
  const unsigned lds0=(unsigned)(uintptr_t)shm;
  float*wsf=(float*)(shm+LDS_WS)+wid*64;
  const bf16*ksrc=Kh+(long)lane*DM+wid*8;
  const bf16*vsrc=Vh+(long)(16*(wid&3)+(lane>>2))*DM+(wid>>2)*32+(lane&3)*8;
  const unsigned kdst=lds0+LDS_K+wid*1024, vdst=lds0+LDS_V+wid*1024;
  #define DMA_K(t,slot) glds16(ksrc+(long)(t)*KVBLK*DM,(unsigned)__builtin_amdgcn_readfirstlane(kdst+(slot)))
  #define DMA_V(t,slot) do{ glds16(vsrc+(long)(t)*KVBLK*DM,(unsigned)__builtin_amdgcn_readfirstlane(vdst+2*(slot))); glds16(vsrc+64+(long)(t)*KVBLK*DM,(unsigned)__builtin_amdgcn_readfirstlane(vdst+8192+2*(slot))); }while(0)
  const int vb0=(int)(lds0+LDS_V)+((lane>>4)&1)*32+(lane&3)*8+(4*hi+((lane&15)>>2))*64;
  const char*Kbase=shm+LDS_K; bf16x8 kf[8];
  const lds_cptr shm3=(lds_cptr)shm; const lds_cptr kp0=shm3+LDS_K+hi*1024+r32*16; const lds_cptr vp0=shm3+LDS_V+((lane>>4)&1)*32+(lane&3)*8+(4*hi+((lane&15)>>2))*64;
  const int NT=(q0+QB)/KVBLK;
  if(!pre){DMA_K(0,0);DMA_V(0,0);DMA_K(1,SLOTB);}
  bf16x8 qr[4];
  #pragma unroll
  for(int d0=0;d0<4;++d0)qr[d0]=*reinterpret_cast<const bf16x8*>(&Qw[(long)r32*DM+d0*16+hi*8]);
  float mhat=0.f,l_reg=0.f;f32x16 o[4];o[0]=f32x16{};o[1]=f32x16{};o[2]=f32x16{};o[3]=f32x16{};
  const int qrel=wid*QBLK+r32;
  #define CMASK(P0,P1,t) do{int jb_=(t)-(NT-4); if(jb_>=0)cmask(P0,P1,jb_,qrel,hi);}while(0)
  bool resc=false;
  #define START(P0,P1) do{ const float rm=rowmax(P0,P1); resc=false; \
    { const float dl=rm; mhat=fadd_s(mhat,dl); \
      _Pragma("unroll") for(int r=0;r<16;++r){P0[r]=fsub_s(P0[r],dl);P1[r]=fsub_s(P1[r],dl);} \
      } \
    _Pragma("unroll") for(int r=0;r<16;++r)P0[r]=__builtin_amdgcn_exp2f(P0[r]); }while(0)
  #define RESC() do{ if(resc){ asm volatile("s_waitcnt lgkmcnt(0)":::"memory"); \
      _Pragma("unroll") for(int d_=0;d_<4;++d_) _Pragma("unroll") for(int r=0;r<16;++r)o[d_][r]*=wsf[crow(r,hi)]; } }while(0)
  f32x16 pA0,pA1,pB0,pB1;
  int sl_prev=0,sl_cur=0,sl_next=SLOTB;
  #define ROT() do{sl_prev=sl_cur;sl_cur=sl_next;sl_next=(sl_next==(NSLOT-1)*SLOTB)?0:sl_next+SLOTB;}while(0)
  if(!pre){DMA_K(2,2*SLOTB);}
  WAIT_BAR(3);
  qkt(pA0,pA1,Kbase,qr,r32,hi);asm volatile("s_nop 15\n\ts_nop 7":"+v"(pA0),"+v"(pA1));CMASK(pA0,pA1,0);
  START(pA0,pA1);
  _Pragma("unroll") for(int r=0;r<16;++r)pA1[r]=__builtin_amdgcn_exp2f(pA1[r]);
  WAIT_BAR(0);
  DMA_K(3,0);DMA_V(1,SLOTB);
  ROT();
  kload8(kf,kp0+sl_cur);
  WAIT_BAR(3);
  s16x4 vlo[4],vhi[4]; u32x4 pw0,pw1,pw2,pw3;
  #define PKW(P,B) cvtpk_s(P[B],P[B+1])
  #define PAF(k) __builtin_bit_cast(bf16x8,pw##k)
  #define VFRW(s) (bf16x8){vlo[s][0],vlo[s][1],vlo[s][2],vlo[s][3],vhi[s][0],vhi[s][1],vhi[s][2],vhi[s][3]}
  #define PIN(x) asm volatile("":"+v"(x))
  #define MX3(a,b,c) __builtin_fmaxf(__builtin_fmaxf((a),(b)),(c))
  #define GAPA(MF,A0,A1,A2,A3,W0,W1,PW) do{ MF; sacc+=A0; sacc+=A1; sacc+=A2; sacc+=A3; PIN(sacc); W0; W1; PIN(PW); SBAR(); }while(0)
  #define EX(v) __builtin_amdgcn_exp2f(v)
  #define GAPB(MF,X,B) do{ MF; X[B]=EX(X[B]); X[B+1]=EX(X[B+1]); PIN(X); SBAR(); }while(0)
  #define VOFF(f) ((2*((f)>>3)+((f)&1))*4096+(((f)&7)>>1)*1024)
  #define VRDW(f) do{ vlo[(f)&3]=vtr(vp_+VOFF(f)); vhi[(f)&3]=vtr(vp_+VOFF(f)+512); }while(0)
  #define KRD(G,j) do{ if(G){ kload2(kf,kp0+sl_next,j); SBAR(); } }while(0)
  #define STEP(C0,C1,P0,P1,t,GK,GV,GL) do{ SBAR(); \
    const lds_cptr vp_=vp0+2*sl_prev; \
    VRDW(0); SBAR(); float sacc=(P0[0]+P0[1]); \
    GAPA(C0=__builtin_amdgcn_mfma_f32_32x32x16_bf16(kf[0],qr[0],f32x16{},0,0,0), P0[2],P0[3],P0[4],P0[5],     pw0[0]=PKW(P0,0), pw0[1]=PKW(P0,2), pw0); \
    VRDW(1); SBAR(); GAPA(C1=__builtin_amdgcn_mfma_f32_32x32x16_bf16(kf[1],qr[0],f32x16{},0,0,0), P0[6],P0[7],P0[8],P0[9],     pw0[2]=PKW(P0,4), pw0[3]=PKW(P0,6), pw0); \
    VRDW(2); SBAR(); GAPA(C0=__builtin_amdgcn_mfma_f32_32x32x16_bf16(kf[2],qr[1],C0,0,0,0),   P0[10],P0[11],P0[12],P0[13], pw1[0]=PKW(P0,8), pw1[1]=PKW(P0,10), pw1); \
    VRDW(3); SBAR(); GAPA(C1=__builtin_amdgcn_mfma_f32_32x32x16_bf16(kf[3],qr[1],C1,0,0,0),   P0[14],P0[15],P1[0],P1[1],   pw1[2]=PKW(P0,12),pw1[3]=PKW(P0,14), pw1); \
    GAPA(C0=__builtin_amdgcn_mfma_f32_32x32x16_bf16(kf[4],qr[2],C0,0,0,0),   P1[2],P1[3],P1[4],P1[5],     pw2[0]=PKW(P1,0), pw2[1]=PKW(P1,2), pw2); \
    GAPA(C1=__builtin_amdgcn_mfma_f32_32x32x16_bf16(kf[5],qr[2],C1,0,0,0),   P1[6],P1[7],P1[8],P1[9],     pw2[2]=PKW(P1,4), pw2[3]=PKW(P1,6), pw2); \
    GAPA(C0=__builtin_amdgcn_mfma_f32_32x32x16_bf16(kf[6],qr[3],C0,0,0,0),   P1[10],P1[11],P1[12],P1[13], pw3[0]=PKW(P1,8), pw3[1]=PKW(P1,10), pw3); \
    GAPA(C1=__builtin_amdgcn_mfma_f32_32x32x16_bf16(kf[7],qr[3],C1,0,0,0),   P1[14],P1[15],0.f,0.f,       pw3[2]=PKW(P1,12),pw3[3]=PKW(P1,14), pw3); \
    l_reg+=sacc; \
    _Pragma("unroll") for(int r=0;r<16;++r){C0[r]-=mhat;C1[r]-=mhat;} \
    if(GK){DMA_K((t)+3,sl_cur);} if(GV){DMA_V((t)+1,sl_next);} \
    CMASK(C0,C1,t); \
    { float a=MX3(C0[0],C0[1],C1[0]),b=MX3(C0[2],C0[3],C1[1]); a=MX3(a,C1[2],C1[3]); \
      _Pragma("unroll") for(int r=4;r<16;r+=4){a=MX3(a,C0[r],C0[r+1]);b=MX3(b,C0[r+2],C0[r+3]);a=MX3(a,C1[r],C1[r+1]);b=MX3(b,C1[r+2],C1[r+3]);} \
      float rm=__builtin_fmaxf(a,b); { auto rr=__builtin_amdgcn_permlane32_swap(__float_as_uint(rm),__float_as_uint(rm),false,false); rm=__builtin_fmaxf(__uint_as_float(rr[0]),__uint_as_float(rr[1])); } \
      resc=false; \
      if(__builtin_expect(__any(rm>(float)THRL),0)){ const float dl=__builtin_fmaxf(rm,0.f); mhat+=dl; \
        _Pragma("unroll") for(int r=0;r<16;++r){C0[r]-=dl;C1[r]-=dl;} \
        const float f=__builtin_amdgcn_exp2f(-dl); l_reg*=f; if(hi==0)wsf[r32]=f; resc=true; } } \
    SBAR(); \
    GAPB(o[0]=__builtin_amdgcn_mfma_f32_32x32x16_bf16(PAF(0),VFRW(0),o[0],0,0,0), C0,0);  VRDW(4);  SBAR(); \
    GAPB(o[1]=__builtin_amdgcn_mfma_f32_32x32x16_bf16(PAF(0),VFRW(1),o[1],0,0,0), C0,2);  VRDW(5);  SBAR(); \
    KRD(GL,0); GAPB(o[0]=__builtin_amdgcn_mfma_f32_32x32x16_bf16(PAF(1),VFRW(2),o[0],0,0,0), C0,4);  VRDW(6);  SBAR(); \
    KRD(GL,1); GAPB(o[1]=__builtin_amdgcn_mfma_f32_32x32x16_bf16(PAF(1),VFRW(3),o[1],0,0,0), C0,6);  VRDW(7);  SBAR(); \
    KRD(GL,2); GAPB(o[0]=__builtin_amdgcn_mfma_f32_32x32x16_bf16(PAF(2),VFRW(0),o[0],0,0,0), C0,8);  VRDW(8);  SBAR(); \
    KRD(GL,3); GAPB(o[1]=__builtin_amdgcn_mfma_f32_32x32x16_bf16(PAF(2),VFRW(1),o[1],0,0,0), C0,10); VRDW(9);  SBAR(); \
    GAPB(o[0]=__builtin_amdgcn_mfma_f32_32x32x16_bf16(PAF(3),VFRW(2),o[0],0,0,0), C0,12); VRDW(10); SBAR(); \
    GAPB(o[1]=__builtin_amdgcn_mfma_f32_32x32x16_bf16(PAF(3),VFRW(3),o[1],0,0,0), C0,14); VRDW(11); SBAR(); \
    GAPB(o[2]=__builtin_amdgcn_mfma_f32_32x32x16_bf16(PAF(0),VFRW(0),o[2],0,0,0), C1,0);  VRDW(12); SBAR(); \
    GAPB(o[3]=__builtin_amdgcn_mfma_f32_32x32x16_bf16(PAF(0),VFRW(1),o[3],0,0,0), C1,2);  VRDW(13); SBAR(); \
    GAPB(o[2]=__builtin_amdgcn_mfma_f32_32x32x16_bf16(PAF(1),VFRW(2),o[2],0,0,0), C1,4);  VRDW(14); SBAR(); \
    GAPB(o[3]=__builtin_amdgcn_mfma_f32_32x32x16_bf16(PAF(1),VFRW(3),o[3],0,0,0), C1,6);  VRDW(15); SBAR(); \
    GAPB(o[2]=__builtin_amdgcn_mfma_f32_32x32x16_bf16(PAF(2),VFRW(0),o[2],0,0,0), C1,8); \
    GAPB(o[3]=__builtin_amdgcn_mfma_f32_32x32x16_bf16(PAF(2),VFRW(1),o[3],0,0,0), C1,10); \
    GAPB(o[2]=__builtin_amdgcn_mfma_f32_32x32x16_bf16(PAF(3),VFRW(2),o[2],0,0,0), C1,12); \
    GAPB(o[3]=__builtin_amdgcn_mfma_f32_32x32x16_bf16(PAF(3),VFRW(3),o[3],0,0,0), C1,14); \
    }while(0)
  int t=1;
  #undef CMASK
  #define CMASK(P0,P1,t) do{}while(0)
  for(;t+5<NT;t+=2){
    STEP(pB0,pB1,pA0,pA1,t,true,true,true);     WAIT_BAR(3); RESC(); ROT();
    STEP(pA0,pA1,pB0,pB1,t+1,true,true,true);   WAIT_BAR(3); RESC(); ROT();
  }
  #undef CMASK
  #define CMASK(P0,P1,t) do{int jb_=(t)-(NT-4); if(jb_>=0)cmask(P0,P1,jb_,qrel,hi);}while(0)
  #define ENDW(tt) do{ if((tt)+3<NT){WAIT_BAR(3);} else if((tt)+2<NT){WAIT_BAR(2);} else {WAIT_BAR(0);} }while(0)
  for(;t+1<NT;t+=2){
    STEP(pB0,pB1,pA0,pA1,t,(t+3<NT),(t+1<NT),(t+1<NT));       ENDW(t);   RESC(); ROT();
    STEP(pA0,pA1,pB0,pB1,t+1,(t+4<NT),(t+2<NT),(t+2<NT));     ENDW(t+1); RESC(); ROT();
  }
  STEP(pB0,pB1,pA0,pA1,NT-1,false,false,false); RESC();
  { float sacc=pB0[0]+pB0[1]; _Pragma("unroll") for(int r=2;r<16;++r)sacc+=pB0[r]; _Pragma("unroll") for(int r=0;r<16;++r)sacc+=pB1[r]; l_reg+=sacc;
    pw0=(u32x4){PKW(pB0,0),PKW(pB0,2),PKW(pB0,4),PKW(pB0,6)};pw1=(u32x4){PKW(pB0,8),PKW(pB0,10),PKW(pB0,12),PKW(pB0,14)};pw2=(u32x4){PKW(pB1,0),PKW(pB1,2),PKW(pB1,4),PKW(pB1,6)};pw3=(u32x4){PKW(pB1,8),PKW(pB1,10),PKW(pB1,12),PKW(pB1,14)};
    SBAR(); pv(o,vb0+2*sl_cur,PAF(0),PAF(1),PAF(2),PAF(3)); }
  asm volatile("s_waitcnt lgkmcnt(0)\n\ts_barrier":::"memory");
  if(nxt){ int l2=lane; asm volatile("":"+v"(l2));
    const bf16*ks2=Kh+(long)l2*DM+wid*8; const bf16*vs2=Vh+(long)(16*(wid&3)+(l2>>2))*DM+(wid>>2)*32+(l2&3)*8;
    glds16(ks2,(unsigned)__builtin_amdgcn_readfirstlane(kdst)); glds16(vs2,(unsigned)__builtin_amdgcn_readfirstlane(vdst)); glds16(vs2+64,(unsigned)__builtin_amdgcn_readfirstlane(vdst+8192));
    glds16(ks2+(long)KVBLK*DM,(unsigned)__builtin_amdgcn_readfirstlane(kdst+SLOTB)); glds16(ks2+(long)2*KVBLK*DM,(unsigned)__builtin_amdgcn_readfirstlane(kdst+2*SLOTB)); }
  #undef PKW
  #undef PAF
  #undef VFRW
  #undef VOFF
  #undef PIN
  #undef MX3
  #undef GAPA
  #undef GAPB
  #undef EX
  #undef VRDW
  #undef KRD
  #undef STEP
  #undef ENDW
  {auto rr=__builtin_amdgcn_permlane32_swap(__float_as_uint(l_reg),__float_as_uint(l_reg),false,false);l_reg=__uint_as_float(rr[0])+__uint_as_float(rr[1]);}
  if(hi==0)wsf[32+r32]=l_reg;asm volatile("s_waitcnt lgkmcnt(0)":::"memory");
  float rli[16];
  #pragma unroll
  for(int r=0;r<16;++r)rli[r]=__builtin_amdgcn_rcpf(wsf[32+crow(r,hi)]);
  bf16*Ow=O+(rowbase+q0+wid*QBLK)*OPITCH;
  { bf16*stg=(bf16*)(shm+LDS_OST)+wid*4096;
    #pragma unroll
    for(int r=0;r<16;++r){const int orow=crow(r,hi);
      #pragma unroll
      for(int d0=0;d0<4;++d0)stg[orow*128+d0*32+r32]=__float2bfloat16(o[d0][r]*rli[r]);}
    asm volatile("s_waitcnt lgkmcnt(0)":::"memory");
    #pragma unroll
    for(int i=0;i<8;++i){const int row=i*4+(lane>>4),ch=lane&15; const u32x4 v=*(const u32x4*)(stg+row*128+ch*8); ATTN_STORE16(Ow+(long)row*OPITCH+ch*8,v);} }
  asm volatile("s_waitcnt lgkmcnt(0)":::"memory");
  #undef DMA_K
  #undef DMA_V
  #undef CMASK
  #undef START
  #undef RESC
  #undef ROT
}
constexpr int ATTN_LDS_BYTES=LDS_BYTES;
#undef SBAR
#undef WAIT_BAR
}
#define LAS __attribute__((address_space(3)))
typedef unsigned short bf16;
typedef unsigned u32x4 __attribute__((ext_vector_type(4)));
typedef unsigned u32x2 __attribute__((ext_vector_type(2)));
typedef float f32x4 __attribute__((ext_vector_type(4)));
typedef float f32x2 __attribute__((ext_vector_type(2)));
typedef float f32x16 __attribute__((ext_vector_type(16)));
typedef short bf16x8 __attribute__((ext_vector_type(8)));
typedef __bf16 bf16x2_t __attribute__((ext_vector_type(2)));

constexpr int NWAVES = 8, NTHR = 512;
constexpr int MT = 16384, DMOD = 2048, SEQL = 4096, IN0W = 7168;
constexpr float EPS = 1e-6f;
constexpr size_t MiB = 1u << 20;
constexpr size_t WS_LAM32 = 64 * 1024;
constexpr size_t WS_R0 = 192 * 1024;
constexpr size_t WS_SUMSQ = 128 * 1024, WS_ZERO_BYTES = 192 * 1024;
constexpr size_t WS_ROT = 1 * MiB;
constexpr size_t WS_WIN0 = 2 * MiB, WS_WOUT0 = 30 * MiB, WS_WIN1 = 38 * MiB, WS_WGLU = 54 * MiB, WS_WOUT1 = 62 * MiB;
constexpr size_t WS_TF = 70 * MiB, WS_WF = 74 * MiB, WS_VF = 90 * MiB;
constexpr size_t WS_H = 112 * MiB;
constexpr size_t WS_PROJ = 176 * MiB;
constexpr size_t WS_UGM = 176 * MiB, WS_GATE = 240 * MiB, WS_Z = 304 * MiB;
constexpr size_t WS_CAT = 400 * MiB;
constexpr size_t WS_OUT2 = 432 * MiB, WS_END = 496 * MiB;
constexpr int RING_BYTES = 131072, LDS_BYTES = 163840, MISC_OFF = LDS_BYTES - 512;
constexpr int NPH = 11;

__device__ __forceinline__ unsigned pkbf(float lo, float hi) { f32x2 v = {lo, hi}; bf16x2_t b = __builtin_convertvector(v, bf16x2_t); return __builtin_bit_cast(unsigned, b); }
__device__ __forceinline__ float bflo(unsigned u) { return __uint_as_float(u << 16); }
__device__ __forceinline__ float bfhi(unsigned u) { return __uint_as_float(u & 0xffff0000u); }
__device__ __forceinline__ float sigm(float x) { return __builtin_amdgcn_rcpf(1.0f + __expf(-x)); }
__device__ __forceinline__ float siluf(float x) { return x * sigm(x); }
__device__ __forceinline__ float gelu_tanh(float x) { return x * sigm(1.5957691216057308f * (x + 0.044715f * x * x * x)); }
__device__ __forceinline__ float wave_sum(float v) {
#pragma unroll
    for (int o = 1; o < 64; o <<= 1) v += __shfl_xor(v, o);
    return v;
}
__device__ __forceinline__ int crow(int r, int hi) { return (r & 3) + 8 * (r >> 2) + 4 * hi; }
__device__ __forceinline__ float red_frac(double th) { const double rev = th * 0.15915494309189535; return (float)(rev - rint(rev)); }
__device__ __forceinline__ float red_angle(double th) { const double rev = th * 0.15915494309189535; const double fr = rev - rint(rev); return (float)(fr * 6.283185307179586); }

typedef __attribute__((address_space(1))) unsigned gu32;
#define XB_TMO      128
#define XB_XCNT(j)  (256  + 64 * (j))
#define XB_XSUB(j)  (1280 + 64 * (j))
#define XB_XGEN(j)  (2304 + 64 * (j))
#define XB_TOP      3328
#define XB_TOPGEN   3392
#define XCD_BAR_WORDS 3456
#define XB_SPIN_CAP (1u << 18)

__device__ __forceinline__ unsigned xb_ld(unsigned* p)              { return __hip_atomic_load(p, __ATOMIC_RELAXED, __HIP_MEMORY_SCOPE_AGENT); }
__device__ __forceinline__ unsigned xb_add(unsigned* p, unsigned v) { return __hip_atomic_fetch_add(p, v, __ATOMIC_RELAXED, __HIP_MEMORY_SCOPE_AGENT); }
__device__ __forceinline__ unsigned xb_xcc_id() { return (unsigned)__builtin_amdgcn_s_getreg((3 << 11) | 20) & 0xFu; }
#define XB_SPIN(cond, bar) do { unsigned _sp = 0; while (cond) { __builtin_amdgcn_s_sleep(1); \
    if ((++_sp & 255u) == 0u) { if (xb_ld(&(bar)[XB_TMO])) break; if (_sp > XB_SPIN_CAP) { atomicAdd(&(bar)[XB_TMO], 1u); break; } } } } while (0)

struct XcdBarrier {
    unsigned* bar; unsigned x;
    volatile LAS unsigned* st;
};

__device__ __forceinline__ XcdBarrier xcd_barrier_post(unsigned* bar, volatile LAS unsigned* st) {
    XcdBarrier b; b.bar = bar; b.x = xb_xcc_id(); b.st = st;
    if (threadIdx.x == 0) (void)xb_add(&bar[XB_XCNT(b.x)], 1u);
    return b;
}
__device__ __forceinline__ void xcd_barrier_complete(unsigned* bar, unsigned x, unsigned& nloc, unsigned& nx) {
    const unsigned G = gridDim.x * gridDim.y * gridDim.z;
    unsigned sum, cnt, mine, sp = 0u;
    for (;;) {
        sum = 0u; cnt = 0u; mine = 0u;
#pragma unroll
        for (unsigned j = 0; j < 16; ++j) { const unsigned c = xb_ld(&bar[XB_XCNT(j)]); sum += c; cnt += (c > 0u) ? 1u : 0u; mine = (j == x) ? c : mine; }
        if (sum == G) break;
        __builtin_amdgcn_s_sleep(1);
        if ((++sp & 255u) == 0u) { if (xb_ld(&bar[XB_TMO])) break; if (sp > XB_SPIN_CAP) { atomicAdd(&bar[XB_TMO], 1u); break; } }
    }
    nloc = mine > 0u ? mine : 1u; nx = cnt > 0u ? cnt : 1u;
}

__device__ __forceinline__ void xcd_barrier(const XcdBarrier& b) {
    asm volatile("s_waitcnt vmcnt(0)" ::: "memory");
    __syncthreads();
    if (threadIdx.x == 0) {
        unsigned* bar = b.bar;
        __builtin_amdgcn_s_waitcnt(0);
        unsigned nloc = b.st[0], nx = b.st[1];
        if (nloc == 0u) { xcd_barrier_complete(bar, b.x, nloc, nx); b.st[0] = nloc; b.st[1] = nx; }
        const unsigned old = xb_add(&bar[XB_XSUB(b.x)], 1u);
        const unsigned gen = old / nloc;
        if (old + 1u == (gen + 1u) * nloc) {
            __builtin_amdgcn_fence(__ATOMIC_RELEASE, "agent");
            asm volatile("s_waitcnt vmcnt(0)" ::: "memory");
            const unsigned og = xb_add(&bar[XB_TOP], 1u);
            const unsigned tg = og / nx;
            if (og + 1u == (tg + 1u) * nx) xb_add(&bar[XB_TOPGEN], 1u);
            else XB_SPIN(xb_ld(&bar[XB_TOPGEN]) == tg, bar);
            __builtin_amdgcn_fence(__ATOMIC_ACQUIRE, "agent");
            xb_add(&bar[XB_XGEN(b.x)], 1u);
            asm volatile("s_waitcnt vmcnt(0)" ::: "memory");
        } else {
            XB_SPIN(xb_ld(&bar[XB_XGEN(b.x)]) == gen, bar);
            __builtin_amdgcn_fence(__ATOMIC_ACQUIRE, "agent");
            asm volatile("s_waitcnt vmcnt(0)" ::: "memory");
        }
    }
    __syncthreads();
}

struct Args { const float* in[28]; float* out; unsigned char* ws; int ph_lo, ph_hi, mask, pad; };

__device__ __forceinline__ void p0_transpose_item(const float* W, int K, int N, bf16* WT, LAS float* scr, int item, int lane, const float* gk = nullptr, bool glu_perm = false) {
    const int nblk = N / 32, kb = item / nblk, nb = item % nblk, k0 = 64 * kb, n0 = 32 * nb;
    float tv[32];
#pragma unroll
    for (int i = 0; i < 32; ++i) tv[i] = W[(size_t)(k0 + 2 * i + (lane >> 5)) * N + n0 + (lane & 31)];
    if (gk) {
#pragma unroll
        for (int i = 0; i < 32; ++i) tv[i] *= gk[k0 + 2 * i + (lane >> 5)]; }
#pragma unroll
    for (int i = 0; i < 32; ++i) scr[(2 * i + (lane >> 5)) * 33 + (lane & 31)] = tv[i];
    asm volatile("s_waitcnt lgkmcnt(0)" ::: "memory");
    const int c = lane & 7;
#pragma unroll
    for (int j = 0; j < 4; ++j) { const int n = (lane >> 3) + 8 * j; const LAS float* s = scr + (8 * c) * 33 + n;
        u32x4 o; o.x = pkbf(s[0 * 33], s[1 * 33]); o.y = pkbf(s[2 * 33], s[3 * 33]); o.z = pkbf(s[4 * 33], s[5 * 33]); o.w = pkbf(s[6 * 33], s[7 * 33]);
        const int nb0 = !glu_perm || n0 >= 2048 ? n0 : (n0 < 1024 ? 256 * (n0 >> 7) + (n0 & 127) : 256 * ((n0 - 1024) >> 7) + 128 + (n0 & 127));
        *(u32x4*)(WT + (size_t)(nb0 + n) * K + k0 + 8 * c) = o; }
    asm volatile("s_waitcnt lgkmcnt(0)" ::: "memory");
}
__device__ __forceinline__ void row_to_bf16_rs(const float* xrow, bf16* orow, float* rs, int lane) {
    const f32x4* xr = (const f32x4*)xrow + lane;
    f32x4 v[8]; float s = 0.f;
#pragma unroll
    for (int j = 0; j < 8; ++j) { v[j] = xr[64 * j]; s += (v[j].x * v[j].x + v[j].y * v[j].y) + (v[j].z * v[j].z + v[j].w * v[j].w); }
    const float r = 1.0f / sqrtf(wave_sum(s) * (1.0f / DMOD) + EPS);
    if (lane == 0) *rs = r;
    u32x2* o8 = (u32x2*)orow + lane;
#pragma unroll
    for (int j = 0; j < 8; ++j) { u32x2 w; w.x = pkbf(v[j].x, v[j].y); w.y = pkbf(v[j].z, v[j].w); o8[64 * j] = w; }
}
__device__ __forceinline__ void s5_tables(const Args& a, LAS unsigned char* lds, int g, int part, int tid) {
    LAS float* POWr = (LAS float*)lds;
    LAS float* POWi = POWr + 33 * 64;
    LAS float* BBr = POWi + 33 * 64;
    LAS float* BBi = BBr + 1024;
    LAS float* Cr = BBi + 1024;
    LAS float* Ci = Cr + 1024;
    LAS float* KL = Ci + 1024;
    const float* a_re = a.in[17] + g * 64; const float* a_im = a.in[18] + g * 64;
    const float dt = expf(a.in[19][g]);
    for (int idx = tid; idx < 33 * 64; idx += NTHR) { const int k = idx >> 6, p = idx & 63;
        const float ar = a_re[p], ai = a_im[p]; const float mag = expf(ar * dt * (float)k);
        const float fr = red_frac((double)ai * (double)dt * (double)k);
        POWr[idx] = mag * __builtin_amdgcn_cosf(fr); POWi[idx] = mag * __builtin_amdgcn_sinf(fr); }
    for (int idx = tid; idx < 1024; idx += NTHR) { const int p = idx >> 4;
        const float ar = a_re[p], ai = a_im[p];
        const float em1 = expm1f(ar * dt); const float ang = red_angle((double)ai * (double)dt);
        const float sn = sinf(ang), cs = cosf(ang), sh = sinf(0.5f * ang);
        const float nr = em1 * cs - 2.0f * sh * sh, ni = (em1 + 1.0f) * sn;
        const float den = ar * ar + ai * ai; const float fr = (nr * ar + ni * ai) / den, fi = (ni * ar - nr * ai) / den;
        const float br = a.in[20][(size_t)g * 1024 + idx], bi = a.in[21][(size_t)g * 1024 + idx];
        BBr[idx] = fr * br - fi * bi; BBi[idx] = fr * bi + fi * br;
        Cr[idx] = a.in[22][(size_t)g * 1024 + idx]; Ci[idx] = a.in[23][(size_t)g * 1024 + idx]; }
    __syncthreads();
    if (part == 0) {
        const int lag = tid >> 4, m = tid & 15; float acc[16];
#pragma unroll
        for (int q = 0; q < 16; ++q) acc[q] = 0.f;
        for (int p = 0; p < 64; ++p) { const float cr = Cr[m * 64 + p], ci = Ci[m * 64 + p], pr = POWr[lag * 64 + p], pi = POWi[lag * 64 + p];
            const float gr = cr * pr - ci * pi, gi = cr * pi + ci * pr;
#pragma unroll
            for (int q4 = 0; q4 < 4; ++q4) { const f32x4 b_r = *(const LAS f32x4*)(BBr + p * 16 + 4 * q4), b_i = *(const LAS f32x4*)(BBi + p * 16 + 4 * q4);
#pragma unroll
                for (int e = 0; e < 4; ++e) acc[4 * q4 + e] += gr * b_r[e] - gi * b_i[e]; } }
#pragma unroll
        for (int q = 0; q < 16; ++q) KL[(lag * 16 + m) * 16 + q] = acc[q];
    }
    __syncthreads();
    bf16* TF = (bf16*)(a.ws + WS_TF) + (size_t)g * 32 * 64 * 8;
    if (part == 0) for (int idx = tid; idx < 32 * 64; idx += NTHR) { const int dd = idx >> 6, lane = idx & 63, n = lane & 31, kh = lane >> 5; const int lag = dd - 1 + (n >> 4), m = n & 15;
        float v[8];
#pragma unroll
        for (int j = 0; j < 8; ++j) v[j] = (lag >= 0 && lag < 32) ? KL[(lag * 16 + m) * 16 + 8 * kh + j] : 0.f;
        u32x4 w; w.x = pkbf(v[0], v[1]); w.y = pkbf(v[2], v[3]); w.z = pkbf(v[4], v[5]); w.w = pkbf(v[6], v[7]);
        *(u32x4*)(TF + (size_t)idx * 8) = w; }
    bf16* WF = (bf16*)(a.ws + WS_WF) + (size_t)g * 32 * 4 * 64 * 8;
    if (part == 1) for (int idx = tid; idx < 32 * 4 * 64; idx += NTHR) { const int sp = idx >> 8, nt = (idx >> 6) & 3, lane = idx & 63, n = lane & 31, kh = lane >> 5;
        const int pp = 32 * nt + n, p = pp & 63, comp = pp >> 6, k = 31 - sp; const float pr = POWr[k * 64 + p], pi = POWi[k * 64 + p];
        float v[8];
#pragma unroll
        for (int j = 0; j < 8; ++j) { const float br = BBr[p * 16 + 8 * kh + j], bi = BBi[p * 16 + 8 * kh + j]; v[j] = comp ? (pr * bi + pi * br) : (pr * br - pi * bi); }
        u32x4 w; w.x = pkbf(v[0], v[1]); w.y = pkbf(v[2], v[3]); w.z = pkbf(v[4], v[5]); w.w = pkbf(v[6], v[7]);
        *(u32x4*)(WF + (size_t)idx * 8) = w; }
    bf16* VF = (bf16*)(a.ws + WS_VF) + (size_t)g * 16 * 8 * 64 * 8;
    if (part == 1) for (int idx = tid; idx < 16 * 8 * 64; idx += NTHR) { const int jt = idx >> 9, kk = (idx >> 6) & 7, lane = idx & 63, n = lane & 31, kh = lane >> 5;
        const int s = 2 * jt + (n >> 4), m = n & 15;
        float v[8];
#pragma unroll
        for (int j = 0; j < 8; ++j) { const int pp = 16 * kk + 8 * kh + j, p = pp & 63, comp = pp >> 6;
            const float pr = POWr[(s + 1) * 64 + p], pi = POWi[(s + 1) * 64 + p], cr = Cr[m * 64 + p], ci = Ci[m * 64 + p];
            v[j] = comp ? -(cr * pi + ci * pr) : (cr * pr - ci * pi); }
        u32x4 w; w.x = pkbf(v[0], v[1]); w.y = pkbf(v[2], v[3]); w.z = pkbf(v[4], v[5]); w.w = pkbf(v[6], v[7]);
        *(u32x4*)(VF + (size_t)idx * 8) = w; }
    if (part == 0 && tid < 64) { f32x2* L = (f32x2*)(a.ws + WS_LAM32) + g * 64 + tid; *L = (f32x2){POWr[32 * 64 + tid], POWi[32 * 64 + tid]}; }
    __syncthreads();
}

__device__ __forceinline__ void p0_prologue(const Args& a, LAS unsigned char* lds, int tid, int lane, int wave, int G) {
    if (a.mask & 4) for (int it = blockIdx.x; it < 256; it += G) s5_tables(a, lds, it & 127, it >> 7, tid);
    if (a.mask & 8) {
        f32x2* ROT = (f32x2*)(a.ws + WS_ROT);
        for (int idx = blockIdx.x * NTHR + tid; idx < SEQL * 32; idx += G * NTHR) { const int pos = idx >> 5, i = idx & 31;
            const float freq = exp2f(-(float)i * (13.287712379549449f / 32.0f));
            const float ang = red_angle((double)pos * (double)freq);
            ROT[idx] = (f32x2){cosf(ang), sinf(ang)}; }
    }
    LAS float* scr = (LAS float*)(lds + wave * 16384);
    const int gw = blockIdx.x * NWAVES + wave, NGW = G * NWAVES;
    constexpr int I0 = 32 * (IN0W / 32), I1 = 32 * (2048 / 32), I2 = 32 * (4096 / 32);
    constexpr int NITEMS = I0 + I1 + I2 + I1 + I1;
    if (a.mask & 16) for (int it = gw; it < NITEMS; it += NGW) {
        int r = it;
        if (r < I0) { p0_transpose_item(a.in[2], 2048, IN0W, (bf16*)(a.ws + WS_WIN0), scr, r, lane, a.in[1], true); continue; } r -= I0;
        if (r < I1) { p0_transpose_item(a.in[14], 2048, 2048, (bf16*)(a.ws + WS_WOUT0), scr, r, lane); continue; } r -= I1;
        if (r < I2) { p0_transpose_item(a.in[16], 2048, 4096, (bf16*)(a.ws + WS_WIN1), scr, r, lane, a.in[15]); continue; } r -= I2;
        if (r < I1) { p0_transpose_item(a.in[25], 2048, 2048, (bf16*)(a.ws + WS_WGLU), scr, r, lane); continue; } r -= I1;
        p0_transpose_item(a.in[27], 2048, 2048, (bf16*)(a.ws + WS_WOUT1), scr, r, lane);
    }
    if (a.mask & 32) for (int m = gw; m < MT; m += NGW) row_to_bf16_rs(a.in[0] + (size_t)m * DMOD, (bf16*)(a.ws + WS_H) + (size_t)m * DMOD, (float*)(a.ws + WS_R0) + m, lane);
}

struct QKIn { u32x4 x[4]; f32x4 rot[4]; };
__device__ __forceinline__ void qk_load(QKIn& in, const Args& a, int row, int lane) {
    const bf16* base = (const bf16*)(a.ws + WS_PROJ) + (size_t)row * IN0W + 3072 + (lane >> 2) * 64 + (lane & 3) * 8;
    in.x[0] = *(const u32x4*)base; in.x[1] = *(const u32x4*)(base + 32); in.x[2] = *(const u32x4*)(base + 1024); in.x[3] = *(const u32x4*)(base + 1024 + 32);
    const f32x4* rot = (const f32x4*)((const f32x2*)(a.ws + WS_ROT) + (row & (SEQL - 1)) * 32 + (lane & 3) * 8);
#pragma unroll
    for (int q = 0; q < 4; ++q) in.rot[q] = rot[q];
}
__device__ __forceinline__ void qk_finish(const QKIn& in, const Args& a, int row, int lane) {
    float gq[16], gk[16]; { const int i0 = (lane & 3) * 8;
#pragma unroll
        for (int j = 0; j < 8; ++j) { gq[j] = a.in[7][i0 + j]; gq[8 + j] = a.in[7][32 + i0 + j]; gk[j] = a.in[8][i0 + j]; gk[8 + j] = a.in[8][32 + i0 + j]; } }
    bf16* base = (bf16*)(a.ws + WS_PROJ) + (size_t)row * IN0W + 3072 + (lane >> 2) * 64 + (lane & 3) * 8;
#pragma unroll
    for (int which = 0; which < 2; ++which) { const u32x4 x1 = in.x[2 * which], x2 = in.x[2 * which + 1];
        float f1[8], f2[8]; float ss = 0.f;
#pragma unroll
        for (int q = 0; q < 4; ++q) { f1[2 * q] = bflo(x1[q]); f1[2 * q + 1] = bfhi(x1[q]); f2[2 * q] = bflo(x2[q]); f2[2 * q + 1] = bfhi(x2[q]); }
#pragma unroll
        for (int j = 0; j < 8; ++j) ss += f1[j] * f1[j] + f2[j] * f2[j];
        ss += __shfl_xor(ss, 1); ss += __shfl_xor(ss, 2);
        const float sc = __builtin_amdgcn_rsqf(ss * (1.0f / 64.0f) + EPS) * (which == 0 ? 0.125f * 1.4426950408889634f : 1.0f);
        float o1[8], o2[8];
#pragma unroll
        for (int j = 0; j < 8; ++j) { const float y1 = f1[j] * sc * (which == 0 ? gq[j] : gk[j]), y2 = f2[j] * sc * (which == 0 ? gq[8 + j] : gk[8 + j]);
            const float cs = in.rot[j >> 1][2 * (j & 1)], sn = in.rot[j >> 1][2 * (j & 1) + 1];
            o1[j] = y1 * cs - y2 * sn; o2[j] = y2 * cs + y1 * sn; }
        u32x4 w1, w2;
#pragma unroll
        for (int q = 0; q < 4; ++q) { w1[q] = pkbf(o1[2 * q], o1[2 * q + 1]); w2[q] = pkbf(o2[2 * q], o2[2 * q + 1]); }
        *(u32x4*)(base + which * 1024) = w1; *(u32x4*)(base + which * 1024 + 32) = w2; }
}
__device__ __forceinline__ void mixer_a_unit(const Args& a, LAS unsigned char* lds, int unit, int tid, int lane, int wave, int qrow) {
    const int t0 = unit * 32, s0 = t0 & (SEQL - 1);
    const bf16* PROJ = (const bf16*)(a.ws + WS_PROJ);
    QKIn qin[2];
    if (qrow >= 0) { qk_load(qin[0], a, qrow, lane); qk_load(qin[1], a, qrow + 1, lane); }
#pragma unroll 8
    for (int idx = tid; idx < 62 * 128; idx += NTHR) { const int r = idx >> 7, ch = (idx & 127) * 8; u32x4 w = {0u, 0u, 0u, 0u};
        if (s0 - 30 + r >= 0) w = *(const u32x4*)(PROJ + (size_t)(t0 - 30 + r) * IN0W + ch);
        *(LAS u32x4*)(lds + r * 2048 + ch * 2) = w; }
    if (qrow >= 0) { qk_finish(qin[0], a, qrow, lane); __builtin_amdgcn_sched_barrier(0); qk_finish(qin[1], a, qrow + 1, lane); __builtin_amdgcn_sched_barrier(0); }
    __syncthreads();
    {
        f32x2 P[31], w[31];
        const f32x2 cb = *(const f32x2*)(a.in[4] + 2 * tid);
        const float* wp = a.in[3] + 2 * tid; asm volatile("" : "+v"(wp));
#pragma unroll
        for (int j = 0; j < 31; ++j) { P[j] = cb; w[j] = *(const f32x2*)(wp + j * 1024); }
#define CROW(Q, RHO) { const int r = (Q) * 31 + (RHO); const unsigned uw = *(const LAS unsigned*)(lds + r * 2048 + tid * 4); const f32x2 uv = {bflo(uw), bfhi(uw)}; \
        _Pragma("unroll") for (int j = 0; j < 31; ++j) { if ((Q) == 0 ? (j <= (RHO)) : (j >= (RHO))) P[((RHO) - j + 31) % 31] += w[j] * uv; } \
        if (r >= 30) { *(LAS unsigned*)(lds + (r - 30) * 2048 + tid * 4) = pkbf(P[((RHO) + 1) % 31].x, P[((RHO) + 1) % 31].y); P[((RHO) + 1) % 31] = cb; } \
        if (((RHO) & 3) == 3) __builtin_amdgcn_sched_barrier(0); }
#define CROWS(Q) CROW(Q, 0) CROW(Q, 1) CROW(Q, 2) CROW(Q, 3) CROW(Q, 4) CROW(Q, 5) CROW(Q, 6) CROW(Q, 7) CROW(Q, 8) CROW(Q, 9) CROW(Q, 10) CROW(Q, 11) CROW(Q, 12) CROW(Q, 13) CROW(Q, 14) CROW(Q, 15) \
        CROW(Q, 16) CROW(Q, 17) CROW(Q, 18) CROW(Q, 19) CROW(Q, 20) CROW(Q, 21) CROW(Q, 22) CROW(Q, 23) CROW(Q, 24) CROW(Q, 25) CROW(Q, 26) CROW(Q, 27) CROW(Q, 28) CROW(Q, 29) CROW(Q, 30)
        CROWS(0)
        __builtin_amdgcn_sched_barrier(0);
        CROWS(1)
#undef CROWS
#undef CROW
    }
    asm volatile("" ::: "memory"); __builtin_amdgcn_sched_barrier(0);
    if (qrow >= 0) { qk_load(qin[0], a, qrow + 2, lane); qk_load(qin[1], a, qrow + 3, lane); }
    __syncthreads();
    bf16* CAT = (bf16*)(a.ws + WS_CAT);
    {
        u32x4 gt[4][2]; float gg[16], bb[16];
#pragma unroll
        for (int q = 0; q < 4; ++q)
#pragma unroll
            for (int j = 0; j < 2; ++j) gt[q][j] = *(const u32x4*)(PROJ + (size_t)(t0 + wave * 4 + q) * IN0W + 2048 + 512 * j + lane * 8);
#pragma unroll
        for (int j = 0; j < 2; ++j)
#pragma unroll
            for (int e4 = 0; e4 < 2; ++e4) { const f32x4 g4 = *(const f32x4*)(a.in[5] + 512 * j + lane * 8 + 4 * e4), b4 = *(const f32x4*)(a.in[6] + 512 * j + lane * 8 + 4 * e4);
#pragma unroll
                for (int e = 0; e < 4; ++e) { gg[8 * j + 4 * e4 + e] = g4[e]; bb[8 * j + 4 * e4 + e] = b4[e]; } }
#pragma unroll
        for (int q = 0; q < 4; ++q) { const int i = wave * 4 + q; float v[16]; float s = 0.f;
#pragma unroll
            for (int j = 0; j < 2; ++j) { const u32x4 cw = *(const LAS u32x4*)(lds + i * 2048 + (512 * j + lane * 8) * 2);
#pragma unroll
                for (int e = 0; e < 4; ++e) { v[8 * j + 2 * e] = bflo(cw[e]); v[8 * j + 2 * e + 1] = bfhi(cw[e]); } }
#pragma unroll
            for (int e = 0; e < 16; ++e) s += v[e];
            const float mean = wave_sum(s) * (1.0f / 1024.0f); float s2 = 0.f;
#pragma unroll
            for (int e = 0; e < 16; ++e) { v[e] -= mean; s2 += v[e] * v[e]; }
            const float rstd = __builtin_amdgcn_rsqf(wave_sum(s2) * (1.0f / 1024.0f) + EPS);
            const size_t row = (size_t)(t0 + i);
#pragma unroll
            for (int j = 0; j < 2; ++j) { u32x4 o;
#pragma unroll
                for (int e = 0; e < 4; ++e) { const float y0 = v[8 * j + 2 * e] * rstd * gg[8 * j + 2 * e] + bb[8 * j + 2 * e], y1 = v[8 * j + 2 * e + 1] * rstd * gg[8 * j + 2 * e + 1] + bb[8 * j + 2 * e + 1];
                    o[e] = pkbf(siluf(y0) * bflo(gt[q][j][e]), siluf(y1) * bfhi(gt[q][j][e])); }
                *(u32x4*)(CAT + row * DMOD + 512 * j + lane * 8) = o; }
            __builtin_amdgcn_sched_barrier(0); }
    }
    if (qrow >= 0) { qk_finish(qin[0], a, qrow + 2, lane); __builtin_amdgcn_sched_barrier(0); qk_finish(qin[1], a, qrow + 3, lane); }
    __syncthreads();
}
__device__ __forceinline__ void qk_prep_phase(const Args& a, int gw, int NGW, int lane) {
#pragma unroll 1
    for (int r0 = gw * 4; r0 < MT; r0 += NGW * 4) { QKIn in[4];
#pragma unroll
        for (int q = 0; q < 4; ++q) qk_load(in[q], a, r0 + q, lane);
#pragma unroll
        for (int q = 0; q < 4; ++q) { qk_finish(in[q], a, r0 + q, lane); __builtin_amdgcn_sched_barrier(0); } }
}
struct CbIn { u32x4 a0[2], a1[2], bg[2]; };
__device__ __forceinline__ void cb_load(CbIn& in, const Args& a, int row, int lane) {
#pragma unroll
    for (int hg = 0; hg < 2; ++hg) { const int h = hg * 4 + (lane >> 4), j0 = (lane & 15) * 8;
        const bf16* OP = (const bf16*)(a.ws + WS_PROJ) + (size_t)row * IN0W + h * 128 + j0;
        in.a0[hg] = *(const u32x4*)OP; in.a1[hg] = *(const u32x4*)(OP + 1024);
        in.bg[hg] = *(const u32x4*)((const bf16*)(a.ws + WS_PROJ) + (size_t)row * IN0W + 6144 + h * 128 + j0); }
}
__device__ __forceinline__ void cb_finish(const CbIn& in, const Args& a, int row, int lane, float lam, const float (&sg)[8]) {
#pragma unroll
    for (int hg = 0; hg < 2; ++hg) { const int h = hg * 4 + (lane >> 4), j0 = (lane & 15) * 8;
        float o[8]; float ss = 0.f;
#pragma unroll
        for (int q = 0; q < 4; ++q) { o[2 * q] = bflo(in.a0[hg][q]) - lam * bflo(in.a1[hg][q]); o[2 * q + 1] = bfhi(in.a0[hg][q]) - lam * bfhi(in.a1[hg][q]); }
#pragma unroll
        for (int j = 0; j < 8; ++j) ss += o[j] * o[j];
        ss += __shfl_xor(ss, 1); ss += __shfl_xor(ss, 2); ss += __shfl_xor(ss, 4); ss += __shfl_xor(ss, 8);
        const float r = __builtin_amdgcn_rsqf(ss * (1.0f / 128.0f) + EPS) * 0.8f;
        u32x4 w;
#pragma unroll
        for (int q = 0; q < 4; ++q) w[q] = pkbf(o[2 * q] * r * sg[2 * q] * bflo(in.bg[hg][q]), o[2 * q + 1] * r * sg[2 * q + 1] * bfhi(in.bg[hg][q]));
        *(u32x4*)((bf16*)(a.ws + WS_CAT) + (size_t)row * DMOD + 1024 + h * 128 + j0) = w; }
}
__device__ __forceinline__ void combine_phase(const Args& a, int gw, int NGW, int lane, float lam) {
    float sg[8];
#pragma unroll
    for (int j = 0; j < 8; ++j) sg[j] = a.in[13][(lane & 15) * 8 + j];
#pragma unroll 1
    for (int r0 = gw * 4; r0 < MT; r0 += NGW * 4) { CbIn in[4];
#pragma unroll
        for (int q = 0; q < 4; ++q) cb_load(in[q], a, r0 + q, lane);
#pragma unroll
        for (int q = 0; q < 4; ++q) { cb_finish(in[q], a, r0 + q, lane, lam, sg); __builtin_amdgcn_sched_barrier(0); } }
}

constexpr int UPITCH = 1040, HPITCH = 272, S5_UIMG = 0, S5_HIMG = 64 * UPITCH, S5_EBUF = S5_HIMG + 64 * HPITCH, S5_TF = S5_EBUF + 32768, S5_END = S5_TF + 32768;
#define S5_ITEM(step) (bx + ((step) >> 1) * G)
#define S5_USRC(step) ((const u32x4*)((const bf16*)(a.ws + WS_UGM) + ((size_t)(S5_ITEM(step) & 127) * MT + (size_t)(S5_ITEM(step) >> 7) * SEQL + ((step) & 1) * 2048) * 16))
__device__ __forceinline__ void s5_phase(const Args& a, LAS unsigned char* lds, int bx, int G, int tid, int lane, int wave) {
    const int r32 = lane & 31, hi = lane >> 5;
    int nsteps = 0; for (int it = bx; it < 512; it += G) nsteps += 2;
    if (nsteps == 0) return;
    u32x4 upre[8];
    { const u32x4* src = S5_USRC(0);
#pragma unroll
      for (int ps = 0; ps < 8; ++ps) upre[ps] = src[ps * NTHR + tid]; }
    float hr = 0.f, him = 0.f, dsk = 0.f; f32x2 l32 = {0.f, 0.f};
#pragma unroll 1
    for (int step = 0; step < nsteps; ++step) {
        const int item = S5_ITEM(step), g = item & 127, b = item >> 7, half = step & 1;
        const bf16x8* WF = (const bf16x8*)(a.ws + WS_WF) + (size_t)g * 32 * 4 * 64 + lane;
        const bf16x8* VF = (const bf16x8*)(a.ws + WS_VF) + (size_t)g * 16 * 8 * 64 + lane;
#pragma unroll
        for (int ps = 0; ps < 8; ++ps) { const int idx = ps * NTHR + tid; *(LAS u32x4*)(lds + S5_UIMG + (idx >> 6) * UPITCH + (idx & 63) * 16) = upre[ps]; }
        if (half == 0) {
            const u32x4* tsrc = (const u32x4*)(a.ws + WS_TF) + (size_t)g * 2048;
            u32x4 tv[4];
#pragma unroll
            for (int ps = 0; ps < 4; ++ps) tv[ps] = tsrc[ps * NTHR + tid];
            hr = 0.f; him = 0.f; dsk = a.in[24][g * 16 + (r32 & 15)];
            if (wave == 0) l32 = ((const f32x2*)(a.ws + WS_LAM32))[g * 64 + lane];
#pragma unroll
            for (int ps = 0; ps < 4; ++ps) *(LAS u32x4*)(lds + S5_TF + (ps * NTHR + tid) * 16) = tv[ps];
        }
        __syncthreads();
        {
            const int mt = wave >> 2, nt = wave & 3; f32x16 acc = {};
            const LAS unsigned char* ap = lds + S5_UIMG + (32 * mt + r32) * UPITCH + hi * 16;
#pragma unroll 16
            for (int sp = 0; sp < 32; ++sp) { const bf16x8 A = *(const LAS bf16x8*)(ap + sp * 32); const bf16x8 B = WF[(sp * 4 + nt) * 64];
                acc = __builtin_amdgcn_mfma_f32_32x32x16_bf16(A, B, acc, 0, 0, 0); }
            LAS float* E = (LAS float*)(lds + S5_EBUF);
#pragma unroll
            for (int i = 0; i < 16; ++i) E[(32 * mt + crow(i, hi)) * 128 + 32 * nt + r32] = acc[i];
        }
        __syncthreads();
        if (wave == 0) {
            const LAS float* E = (const LAS float*)(lds + S5_EBUF); LAS bf16* H = (LAS bf16*)(lds + S5_HIMG);
#pragma unroll 1
            for (int c0 = 0; c0 < 64; c0 += 8) { float er[8], ei[8];
#pragma unroll
                for (int q = 0; q < 8; ++q) { er[q] = E[(c0 + q) * 128 + lane]; ei[q] = E[(c0 + q) * 128 + 64 + lane]; }
#pragma unroll
                for (int q = 0; q < 8; ++q) { const unsigned pk = pkbf(hr, him); H[(c0 + q) * (HPITCH / 2) + lane] = (bf16)(pk & 0xffffu); H[(c0 + q) * (HPITCH / 2) + 64 + lane] = (bf16)(pk >> 16);
                    const float nr = l32.x * hr - l32.y * him + er[q], ni = l32.x * him + l32.y * hr + ei[q]; hr = nr; him = ni; } }
        }
        __syncthreads();
        f32x16 acc[2][2];
#pragma unroll
        for (int jj = 0; jj < 2; ++jj) { const int j = jj ? 15 - wave : wave; acc[jj][0] = (f32x16){}; acc[jj][1] = (f32x16){};
            bf16x8 vfr[8];
#pragma unroll
            for (int kk = 0; kk < 8; ++kk) vfr[kk] = VF[(j * 8 + kk) * 64];
            const LAS unsigned char* ap = lds + S5_UIMG + r32 * UPITCH + hi * 16; const LAS unsigned char* tp = lds + S5_TF + lane * 16; const int nks = 2 * j + 2;
#pragma unroll 4
            for (int sp = 0; sp < nks; ++sp) { const bf16x8 B = *(const LAS bf16x8*)(tp + (2 * j + 1 - sp) * 1024); const bf16x8 A0 = *(const LAS bf16x8*)(ap + sp * 32), A1 = *(const LAS bf16x8*)(ap + 32 * UPITCH + sp * 32);
                acc[jj][0] = __builtin_amdgcn_mfma_f32_32x32x16_bf16(A0, B, acc[jj][0], 0, 0, 0); acc[jj][1] = __builtin_amdgcn_mfma_f32_32x32x16_bf16(A1, B, acc[jj][1], 0, 0, 0); }
            const LAS unsigned char* hp = lds + S5_HIMG + r32 * HPITCH + hi * 16;
#pragma unroll
            for (int kk = 0; kk < 8; ++kk) { const bf16x8 A0 = *(const LAS bf16x8*)(hp + kk * 32), A1 = *(const LAS bf16x8*)(hp + 32 * HPITCH + kk * 32);
                acc[jj][0] = __builtin_amdgcn_mfma_f32_32x32x16_bf16(A0, vfr[kk], acc[jj][0], 0, 0, 0); acc[jj][1] = __builtin_amdgcn_mfma_f32_32x32x16_bf16(A1, vfr[kk], acc[jj][1], 0, 0, 0); }
        }
        if (step + 1 < nsteps) { const u32x4* src = S5_USRC(step + 1);
#pragma unroll
            for (int ps = 0; ps < 8; ++ps) upre[ps] = src[ps * NTHR + tid]; }
        __syncthreads();
#pragma unroll
        for (int jj = 0; jj < 2; ++jj) { const int j = jj ? 15 - wave : wave;
#pragma unroll
            for (int mt = 0; mt < 2; ++mt)
                { LAS bf16* ub = (LAS bf16*)(lds + S5_UIMG + (32 * mt + 4 * hi) * UPITCH + j * 64 + r32 * 2); unsigned short uu[16];
#pragma unroll
                    for (int i = 0; i < 16; ++i) uu[i] = ub[((i & 3) + 8 * (i >> 2)) * (UPITCH / 2)];
#pragma unroll
                    for (int i = 0; i < 16; ++i) { const float u = __uint_as_float((unsigned)uu[i] << 16); const float v = acc[jj][mt][i] + dsk * u; uu[i] = (unsigned short)(pkbf(gelu_tanh(v), 0.f) & 0xffffu); }
#pragma unroll
                    for (int i = 0; i < 16; ++i) ub[((i & 3) + 8 * (i >> 2)) * (UPITCH / 2)] = uu[i]; } }
        __syncthreads();
        { bf16* Z = (bf16*)(a.ws + WS_Z);
#pragma unroll
          for (int ps = 0; ps < 4; ++ps) { const int idx = ps * NTHR + tid; const LAS unsigned char* sp_ = lds + S5_UIMG + (idx >> 5) * UPITCH + (idx & 31) * 32;
            const u32x4 v0 = *(const LAS u32x4*)sp_, v1 = *(const LAS u32x4*)(sp_ + 16);
            bf16* dst = Z + (size_t)(b * SEQL + half * 2048 + idx) * DMOD + 16 * g; *(u32x4*)dst = v0; *(u32x4*)(dst + 8) = v1; } }
        __syncthreads();
    }
}

#ifndef MK_N_LAUNCHES
#define MK_N_LAUNCHES 1
#endif
__global__ void __launch_bounds__(NTHR, 2) fwd_kernel(Args a) {
    extern __shared__ __attribute__((aligned(16))) unsigned char lds_raw[];
    cg::grid_group grid = cg::this_grid();
    LAS unsigned char* lds = (LAS unsigned char*)lds_raw;
    const int tid = threadIdx.x, lane = tid & 63, wave = __builtin_amdgcn_readfirstlane(tid >> 6), G = gridDim.x;
    const int bx = blockIdx.x; const int vcu = (G % 8 == 0) ? (bx % 8) * (G / 8) + bx / 8 : bx;
    const int gw = bx * NWAVES + wave, NGW = G * NWAVES;
    const int lo = a.ph_lo, hi = a.ph_hi;
    unsigned char* ws = a.ws;
    volatile LAS unsigned* MISC = (volatile LAS unsigned*)(lds + MISC_OFF);
    if (tid < 32) MISC[tid] = 0u;
    __syncthreads();
    XcdBarrier bar = xcd_barrier_post((unsigned*)ws, MISC + 8);
#define IN(k) (lo <= (k) && (k) < hi)
#ifdef PROBE_A
#define STAMP(k) do { if (bx == 0 && tid == 0) ((unsigned long long*)(ws + 32768))[(k)] = __builtin_amdgcn_s_memrealtime(); } while (0)
#else
#define STAMP(k) do {} while (0)
#endif
#define SEAM(k) do { STAMP((k) + 1); if (IN(k) && IN((k) + 1)) { if ((k) == 0 && lo < 0) grid.sync(); else xcd_barrier(bar);     } } while (0)

    STAMP(0);
    if (IN(0)) { p0_prologue(a, lds, tid, lane, wave, G); }
#if defined(TWICE_P) && TWICE_P == 0
    __syncthreads(); p0_prologue(a, lds, tid, lane, wave, G);
#endif
    SEAM(0);
    if (IN(1)) {
        pg8::Gemm g{(const bf16*)(ws + WS_H), (const bf16*)(ws + WS_WIN0), MT, IN0W, DMOD}; pg8::StaticOrder S; S.init(MT, IN0W, G, bx);
        pg8::EpiBf16Row E{(bf16*)(ws + WS_PROJ), IN0W, (const float*)(ws + WS_R0)};
        pg8::gemm_phase<pg8::EpiBf16Row, pg8::StaticOrder, PG8_ALIGN, PG8_SP2>(lds, g, S, E);
    }
    SEAM(1);
    if (IN(2)) {
        const bool fuse = (G == 256) && (a.mask == -1);
        { int k = 0;
#pragma unroll 1
          for (int u = bx; u < MT / 32; u += G, ++k) { if (a.mask & 1) mixer_a_unit(a, lds, u, tid, lane, wave, fuse ? gw * 8 + k * 4 : -1); } }
        if (!fuse && (a.mask & 2)) qk_prep_phase(a, gw, NGW, lane);
    }
    SEAM(2);
#if defined(TWICE_P) && TWICE_P == 3
    for (int rep3 = 0; rep3 < 2; ++rep3)
#endif
    if (IN(3)) {
        const attn_body::bf16* PROJ = (const attn_body::bf16*)(ws + WS_PROJ); attn_body::bf16* OP = (attn_body::bf16*)(ws + WS_PROJ);
        const int per = (512 + G - 1) / G; bool pre = false;
#pragma unroll 1
        for (int ui = 0; ui < 2 * per; ++ui) { const int pi = vcu * per + (ui >> 1); if (pi >= 512) break;
            const int bhc = pi >> 3, s = pi & 7, b = bhc >> 4, h = (bhc >> 1) & 7, c = bhc & 1;
            const int npi = vcu * per + ((ui + 1) >> 1); const bool nxt = (ui + 1 < 2 * per) && (npi < 512) && ((npi >> 3) == bhc);
            const attn_body::bf16* Q = PROJ + 3072 + h * 128 + c * 64; const attn_body::bf16* K = PROJ + 4096 + h * 128 + c * 64; const attn_body::bf16* V = PROJ + 5120 + h * 128;
            attn_body::bf16* O = OP + c * 1024 + h * 128;
            attn_body::attn_unit<8>(b, (ui & 1) ? 15 - s : s, Q, K, V, O, (char*)lds_raw, pre, nxt);
            pre = nxt;
        }
    }
    SEAM(3);
    if (IN(4)) {
        const float p1 = a.in[9][lane] * a.in[10][lane], p2 = a.in[11][lane] * a.in[12][lane];
        const float lam = expf(wave_sum(p1)) - expf(wave_sum(p2)) + 0.2f;
        combine_phase(a, gw, NGW, lane, lam);
    }
    SEAM(4);
    if (IN(5)) {
        pg8::Gemm g{(const bf16*)(ws + WS_CAT), (const bf16*)(ws + WS_WOUT0), MT, DMOD, DMOD}; pg8::StaticOrder S; S.init(MT, DMOD, G, bx);
        pg8::EpiResNorm E{(bf16*)(ws + WS_H), (float*)(ws + WS_SUMSQ)};
        pg8::gemm_phase<pg8::EpiResNorm, pg8::StaticOrder, PG8_ALIGN, PG8_SP2>(lds, g, S, E);
    }
    SEAM(5);
    if (IN(7)) {
        pg8::Gemm g{(const bf16*)(ws + WS_H), (const bf16*)(ws + WS_WIN1), MT, 4096, DMOD}; pg8::StaticOrder S; S.init(MT, 4096, G, bx);
        pg8::EpiUG E{(bf16*)(ws + WS_UGM), (bf16*)(ws + WS_GATE), MT, (const float*)(ws + WS_SUMSQ)};
        pg8::gemm_phase<pg8::EpiUG, pg8::StaticOrder, PG8_ALIGN, PG8_SP2>(lds, g, S, E);
    }
    if (IN(7) && IN(8)) {
        const int g = bx & 127; const int t7 = wave * 64 + (int)__builtin_amdgcn_mbcnt_hi(~0u, __builtin_amdgcn_mbcnt_lo(~0u, 0u)); unsigned acc = 0u;
        const unsigned* wf = (const unsigned*)(ws + WS_WF) + (size_t)g * 32768; const unsigned* vf = (const unsigned*)(ws + WS_VF) + (size_t)g * 32768; const unsigned* tf = (const unsigned*)(ws + WS_TF) + (size_t)g * 8192;
#pragma unroll
        for (int i = 0; i < 2; ++i) { acc ^= wf[(t7 + i * NTHR) * 32]; acc ^= vf[(t7 + i * NTHR) * 32]; }
        if (t7 < 256) acc ^= tf[t7 * 32];
        asm volatile("" :: "v"(acc));
    }
    SEAM(7);
    if (IN(8)) { s5_phase(a, lds, bx, G, tid, lane, wave); }
#if defined(TWICE_P) && TWICE_P == 8
    s5_phase(a, lds, bx, G, tid, lane, wave);
#endif
    SEAM(8);
    if (IN(9)) {
        pg8::Gemm g{(const bf16*)(ws + WS_Z), (const bf16*)(ws + WS_WGLU), MT, DMOD, DMOD}; pg8::StaticOrder S; S.init(MT, DMOD, G, bx);
        pg8::EpiGlu E{(const bf16*)(ws + WS_Z), (const bf16*)(ws + WS_GATE), (bf16*)(ws + WS_OUT2), a.in[26]};
        pg8::gemm_phase<pg8::EpiGlu, pg8::StaticOrder, PG8_ALIGN, PG8_SP2>(lds, g, S, E);
    }
    SEAM(9);
    if (IN(10)) {
        pg8::Gemm g{(const bf16*)(ws + WS_OUT2), (const bf16*)(ws + WS_WOUT1), MT, DMOD, DMOD}; pg8::StaticOrder S; S.init(MT, DMOD, G, bx);
        pg8::EpiResOut E{(const bf16*)(ws + WS_H), a.out};
        pg8::gemm_phase<pg8::EpiResOut, pg8::StaticOrder, PG8_ALIGN, PG8_SP2>(lds, g, S, E);
    }
#ifdef PROBE_XBAR
    for (int q = 0; q < PROBE_XBAR; ++q) xcd_barrier(bar);
#endif
#ifdef PROBE_A
    STAMP(11);
    xcd_barrier(bar);
    if (bx == 0) { const unsigned long long* ts = (const unsigned long long*)(ws + 32768);
        const float dA = (float)(ts[PROBE_A + 1] - ts[PROBE_A]) * 0.01f, dB = (float)(ts[PROBE_B + 1] - ts[PROBE_B]) * 0.01f;
        if (tid == 0) a.out[0] += dA;
        for (int i = tid; i < 4096; i += NTHR) a.out[4096 + i] += dB * 0.125f; }
#endif
#undef IN
#undef SEAM
}

extern "C" void kernel_launch(void* const* d_in, const int* in_sizes, int n_in, void* d_out, int out_size, void* d_ws, size_t ws_size, hipStream_t stream) {
    static int grid = 0;
    if (grid == 0) {
        if (n_in != 28 || in_sizes[0] != MT * DMOD || out_size != MT * DMOD || ws_size < WS_END) { fprintf(stderr, "kernel_launch: unexpected shapes (n_in %d, in0 %d, out %d, ws %zu)\n", n_in, n_in > 0 ? in_sizes[0] : -1, out_size, ws_size); grid = -1; return; }
        int dev = 0, cus = 0, per_cu = 0;
        if (hipGetDevice(&dev) != hipSuccess || hipDeviceGetAttribute(&cus, hipDeviceAttributeMultiprocessorCount, dev) != hipSuccess) { grid = -1; return; }
        if (hipFuncSetAttribute((const void*)fwd_kernel, hipFuncAttributeMaxDynamicSharedMemorySize, LDS_BYTES) != hipSuccess) { fprintf(stderr, "kernel_launch: hipFuncSetAttribute failed\n"); grid = -1; return; }
        if (hipOccupancyMaxActiveBlocksPerMultiprocessor(&per_cu, (const void*)fwd_kernel, NTHR, LDS_BYTES) != hipSuccess || per_cu < 1) { fprintf(stderr, "kernel_launch: occupancy query says %d blocks per CU\n", per_cu); (void)hipGetLastError(); grid = -1; return; }
        grid = cus;
    }
    if (grid < 0) return;
    if (hipMemsetAsync(d_ws, 0, WS_ZERO_BYTES, stream) != hipSuccess) { fprintf(stderr, "kernel_launch: memset failed\n"); return; }
    Args a{};
    for (int i = 0; i < 28; ++i) a.in[i] = (const float*)d_in[i];
    a.out = (float*)d_out; a.ws = (unsigned char*)d_ws;
    void* args[] = {&a};
    a.mask = -1;
#if defined(PROBE_LO)
    a.ph_lo = PROBE_LO; a.ph_hi = PROBE_HI; a.mask = PROBE_MASK;
    (void)hipLaunchCooperativeKernel((const void*)fwd_kernel, dim3(grid), dim3(NTHR), args, LDS_BYTES, stream);
    (void)hipMemsetAsync(d_ws, 0, WS_ZERO_BYTES, stream);
    a.mask = -1;
#endif
#if defined(PROBE_PREFIX)
    a.ph_lo = 0; a.ph_hi = PROBE_PREFIX;
    (void)hipLaunchCooperativeKernel((const void*)fwd_kernel, dim3(grid), dim3(NTHR), args, LDS_BYTES, stream);
    (void)hipMemsetAsync(d_ws, 0, WS_ZERO_BYTES, stream);
#endif
#if MK_N_LAUNCHES == 1
    a.ph_lo = 0; a.ph_hi = NPH;
    hipError_t e = hipLaunchCooperativeKernel((const void*)fwd_kernel, dim3(grid), dim3(NTHR), args, LDS_BYTES, stream);
    if (e != hipSuccess) fprintf(stderr, "kernel_launch: cooperative launch failed: %s (grid %d)\n", hipGetErrorString(e), grid);
#else
    for (int ph = 0; ph < NPH; ++ph) { a.ph_lo = ph; a.ph_hi = ph + 1;
        hipError_t e = hipLaunchCooperativeKernel((const void*)fwd_kernel, dim3(grid), dim3(NTHR), args, LDS_BYTES, stream);
        if (e != hipSuccess) { fprintf(stderr, "kernel_launch: cooperative launch %d failed: %s (grid %d)\n", ph, hipGetErrorString(e), grid); break; } }
#endif
}
```
